# Optimizing an MI355X kernel written in HIP

```python
import math
import jax, jax.numpy as jnp
from jax import lax
import numpy as np

D_MODEL = 1024
BATCH = 32
SEQ = 2048
DEPTH = 1
DEC_BATCH = 32
DEC_SEQ = 64
PAST_LEN = 4096

CHUNK = 64
Q_BLOCK = 128
W_A = 1024
N_LRU_BLOCKS = 8
LRU_BLOCK = W_A // N_LRU_BLOCKS
CONV_W = 4
LRU_C = 8.0
H_B = 8
DK = 64
DV = 128
W_B = H_B * DV
NUM_BUCKETS = 32
MAX_DISTANCE = 128
EPS = 1e-6
IN_COLS = 2 * W_A + 2 * H_B * 2 * DK + 2 * W_B + 2 * D_MODEL

kernel_name = "hawk_diffattn_parallel_stream_step"


def rms_norm(x, g):
    xf = x.astype(jnp.float32)
    y = xf * lax.rsqrt(jnp.mean(xf * xf, axis=-1, keepdims=True) + EPS)
    return (y * g.astype(jnp.float32)).astype(x.dtype)


def split_in(u):
    sizes = [W_A, W_A, H_B * 2 * DK, H_B * 2 * DK, W_B, W_B, D_MODEL, D_MODEL]
    idx = [int(v) for v in np.cumsum(sizes)[:-1]]
    return jnp.split(u, idx, axis=-1)


def rel_bucket(rel):
    nb = NUM_BUCKETS // 2
    max_exact = nb // 2
    n = jnp.abs(rel)
    large = max_exact + (jnp.log(jnp.maximum(n, 1).astype(jnp.float32) / max_exact)
                         / math.log(MAX_DISTANCE / max_exact) * (nb - max_exact)).astype(jnp.int32)
    large = jnp.minimum(large, nb - 1)
    return jnp.where(rel > 0, nb, 0) + jnp.where(n < max_exact, n, large)


def diff_attn(q, k, v, q_pos, k_pos, rel_bias, lam):
    s = jnp.einsum('bqhmd,bkhmd->bhmqk', q.astype(jnp.float32), k.astype(jnp.float32)) * (DK ** -0.5)
    bias = rel_bias.astype(jnp.float32)[rel_bucket(k_pos[None, :] - q_pos[:, None])]
    bias = jnp.transpose(bias, (2, 0, 1))[None, :, None]
    visible = (k_pos[None, :] // CHUNK) <= (q_pos[:, None] // CHUNK)
    s = jnp.where(visible, s + bias, -jnp.inf)
    p = jax.nn.softmax(s, axis=-1)
    w = p[:, :, 0] - lam * p[:, :, 1]
    return jnp.einsum('bhqk,bkhd->bqhd', w, v.astype(jnp.float32))


def rglru(xc, h0, is_first, w_rg, b_rg, w_ig, b_ig, lru_lambda):
    B, T, _ = xc.shape
    xf = xc.astype(jnp.float32)
    xb = xf.reshape(B, T, N_LRU_BLOCKS, LRU_BLOCK)
    r = jax.nn.sigmoid(jnp.einsum('btnc,ncd->btnd', xb, w_rg.astype(jnp.float32)).reshape(B, T, W_A)
                       + b_rg.astype(jnp.float32))
    i = jax.nn.sigmoid(jnp.einsum('btnc,ncd->btnd', xb, w_ig.astype(jnp.float32)).reshape(B, T, W_A)
                       + b_ig.astype(jnp.float32))
    log_a = -LRU_C * r * jax.nn.softplus(-lru_lambda.astype(jnp.float32))
    a = jnp.exp(log_a)
    mult = jnp.sqrt(-jnp.expm1(2.0 * log_a))
    if is_first:
        mult = mult.at[:, 0].set(1.0)
    b = mult * i * xf
    b = b.at[:, 0].add(a[:, 0] * h0.astype(jnp.float32))

    def comb(left, right):
        return (left[0] * right[0], right[0] * left[1] + right[1])

    _, h = lax.associative_scan(comb, (a, b), axis=1)
    return h, h[:, -1]


def mixer_layer(x, conv_prev, h0, k_past, v_past, is_first, lam_init, rel_bias,
                norm_gain, w_in, conv_w, conv_b, w_rg, b_rg, w_ig, b_ig, lru_lambda,
                q_norm_gain, k_norm_gain, lam_q1, lam_k1, lam_q2, lam_k2, subln_gain,
                w_proj_a, w_proj_b, w_out):
    B, T, _ = x.shape
    xn = rms_norm(x, norm_gain)
    u = xn @ w_in
    xa, za, q, k, v, zb, ga, gb = split_in(u)

    xpad = jnp.concatenate([conv_prev.astype(xa.dtype), xa], axis=1)
    new_conv = xpad[:, -(CONV_W - 1):]
    xc = conv_b + sum(xpad[:, j:j + T] * conv_w[j] for j in range(CONV_W))
    h, h_last = rglru(xc, h0, is_first, w_rg, b_rg, w_ig, b_ig, lru_lambda)
    ya = h.astype(x.dtype) * jax.nn.silu(za)

    q = rms_norm(q.reshape(B, T, H_B, 2, DK), q_norm_gain)
    k = rms_norm(k.reshape(B, T, H_B, 2, DK), k_norm_gain)
    v = v.reshape(B, T, H_B, DV)
    lf = lambda t: t.astype(jnp.float32)
    lam = (jnp.exp(jnp.sum(lf(lam_q1) * lf(lam_k1))) - jnp.exp(jnp.sum(lf(lam_q2) * lf(lam_k2)))
           + lam_init)
    if is_first:
        pos = jnp.arange(T)
        outs = []
        for blk in range(T // Q_BLOCK):
            s0, e0 = blk * Q_BLOCK, (blk + 1) * Q_BLOCK
            outs.append(diff_attn(q[:, s0:e0], k[:, :e0], v[:, :e0], pos[s0:e0], pos[:e0], rel_bias, lam))
        o = jnp.concatenate(outs, axis=1)
    else:
        P = k_past.shape[1]
        k_all = jnp.concatenate([k_past.reshape(B, P, H_B, 2, DK).astype(k.dtype), k], axis=1)
        v_all = jnp.concatenate([v_past.astype(v.dtype), v], axis=1)
        pos_all = jnp.arange(P + T)
        o = diff_attn(q, k_all, v_all, pos_all[P:], pos_all, rel_bias, lam)
    o = rms_norm(o, subln_gain) * (1.0 - lam_init)
    yb = o.reshape(B, T, W_B).astype(x.dtype) * jax.nn.silu(zb)

    m = jax.nn.sigmoid(ga) * (ya @ w_proj_a) + jax.nn.sigmoid(gb) * (yb @ w_proj_b)
    y = x + m @ w_out
    return y, k.reshape(B, T, H_B, 2 * DK), v, new_conv, h_last


def setup_inputs(seed: int = 0) -> dict:
    key = jax.random.key(seed)
    ks = jax.random.split(key, 32)
    nrm = lambda kk, shape, s: jax.random.normal(kk, shape, jnp.float32) * s
    a0 = jax.random.uniform(ks[10], (DEPTH, W_A), jnp.float32, 0.9, 0.999)
    sig = a0 ** (1.0 / LRU_C)
    lru_lambda = jnp.log(sig) - jnp.log1p(-sig)
    return {
        "x_prompt": nrm(ks[0], (BATCH, SEQ, D_MODEL), 1.0),
        "x_sample": nrm(ks[1], (DEC_BATCH, DEC_SEQ, D_MODEL), 1.0),
        "cache_k": nrm(ks[2], (DEPTH, DEC_BATCH, PAST_LEN, H_B, 2 * DK), 1.0),
        "cache_v": nrm(ks[3], (DEPTH, DEC_BATCH, PAST_LEN, H_B, DV), 1.0),
        "state_conv": nrm(ks[4], (DEPTH, DEC_BATCH, CONV_W - 1, W_A), 1.0),
        "state_lru": nrm(ks[5], (DEPTH, DEC_BATCH, W_A), 0.5),
        "norm_gain": 1.0 + nrm(ks[6], (DEPTH, D_MODEL), 0.05),
        "w_in": nrm(ks[7], (DEPTH, D_MODEL, IN_COLS), D_MODEL ** -0.5),
        "conv_w": nrm(ks[8], (DEPTH, CONV_W, W_A), CONV_W ** -0.5),
        "conv_b": nrm(ks[9], (DEPTH, W_A), 0.01),
        "w_rg": nrm(ks[11], (DEPTH, N_LRU_BLOCKS, LRU_BLOCK, LRU_BLOCK), LRU_BLOCK ** -0.5),
        "b_rg": nrm(ks[12], (DEPTH, W_A), 0.01),
        "w_ig": nrm(ks[13], (DEPTH, N_LRU_BLOCKS, LRU_BLOCK, LRU_BLOCK), LRU_BLOCK ** -0.5),
        "b_ig": nrm(ks[14], (DEPTH, W_A), 0.01),
        "lru_lambda": lru_lambda,
        "q_norm_gain": 1.0 + nrm(ks[15], (DEPTH, DK), 0.05),
        "k_norm_gain": 1.0 + nrm(ks[16], (DEPTH, DK), 0.05),
        "rel_bias": nrm(ks[17], (NUM_BUCKETS, H_B), 0.2),
        "lam_q1": nrm(ks[18], (DEPTH, DK), 0.1),
        "lam_k1": nrm(ks[19], (DEPTH, DK), 0.1),
        "lam_q2": nrm(ks[20], (DEPTH, DK), 0.1),
        "lam_k2": nrm(ks[21], (DEPTH, DK), 0.1),
        "subln_gain": 1.0 + nrm(ks[22], (DEPTH, DV), 0.05),
        "w_proj_a": nrm(ks[23], (DEPTH, W_A, D_MODEL), W_A ** -0.5),
        "w_proj_b": nrm(ks[24], (DEPTH, W_B, D_MODEL), W_B ** -0.5),
        "w_out": nrm(ks[25], (DEPTH, D_MODEL, D_MODEL), D_MODEL ** -0.5),
    }


def reference(x_prompt, x_sample, cache_k, cache_v, state_conv, state_lru,
              norm_gain, w_in, conv_w, conv_b, w_rg, b_rg, w_ig, b_ig, lru_lambda,
              q_norm_gain, k_norm_gain, rel_bias, lam_q1, lam_k1, lam_q2, lam_k2,
              subln_gain, w_proj_a, w_proj_b, w_out):
    hp, hs = x_prompt, x_sample
    Bp = x_prompt.shape[0]
    kp_l, vp_l, cp_l, sp_l, ks_l, vs_l, cs_l, ss_l = [], [], [], [], [], [], [], []
    for l in range(DEPTH):
        lam_init = 0.8 - 0.6 * math.exp(-0.3 * l)
        lw = (norm_gain[l], w_in[l], conv_w[l], conv_b[l], w_rg[l], b_rg[l], w_ig[l], b_ig[l],
              lru_lambda[l], q_norm_gain[l], k_norm_gain[l], lam_q1[l], lam_k1[l], lam_q2[l],
              lam_k2[l], subln_gain[l], w_proj_a[l], w_proj_b[l], w_out[l])
        conv0 = jnp.zeros((Bp, CONV_W - 1, W_A), hp.dtype)
        h0 = jnp.zeros((Bp, W_A), jnp.float32)
        hp, kp, vp, cp, sp = mixer_layer(hp, conv0, h0, None, None, True, lam_init, rel_bias, *lw)
        hs, kk, vv, cs, ss = mixer_layer(hs, state_conv[l], state_lru[l], cache_k[l], cache_v[l],
                                         False, lam_init, rel_bias, *lw)
        kp_l.append(kp); vp_l.append(vp); cp_l.append(cp); sp_l.append(sp.astype(hp.dtype))
        ks_l.append(kk); vs_l.append(vv); cs_l.append(cs); ss_l.append(ss.astype(state_lru.dtype))
    return (hp, hs,
            jnp.stack(kp_l), jnp.stack(vp_l), jnp.stack(cp_l), jnp.stack(sp_l),
            jnp.stack(ks_l), jnp.stack(vs_l), jnp.stack(cs_l), jnp.stack(ss_l))
```

```cpp
#include <hip/hip_runtime.h>
#include <cstdio>
#include <cstdint>
#include <type_traits>

#ifndef MK_N_LAUNCHES
#define MK_N_LAUNCHES 1
#endif

namespace pg8 {
#define PG8_LAS __attribute__((address_space(3)))
typedef unsigned short bf16_t;
typedef short bf16x8 __attribute__((ext_vector_type(8)));
typedef float f32x4 __attribute__((ext_vector_type(4)));
typedef unsigned u32x4 __attribute__((ext_vector_type(4)));
constexpr int BM = 256, BK = 64, HALF = 128, HTB = HALF * BK * 2, STAGE_BYTES = 8 * HTB, NXCD = 8, WGM = 8;

__host__ __device__ __forceinline__ int lds_byte(int r, int c) { const int st = (r >> 4) * 2 + (c >> 5), rr = r & 15, cc = c & 31, ob = rr * 64 + cc * 2; return st * 1024 + (ob ^ (((ob >> 9) & 1) << 5)); }
__host__ __device__ __forceinline__ void stage_rc(int b, int& R, int& C) { const int st = b / 1024, sb = b % 1024, swz = sb ^ (((sb >> 9) & 1) << 5); R = (st >> 1) * 16 + swz / 64; C = (st & 1) * 32 + (swz % 64) / 2; }
__host__ __device__ __forceinline__ int perm32(int rho) { const int n = rho >> 4, i = rho & 15; return 8 * (i >> 2) + 4 * n + (i & 3); }

struct Unit { int pm, pn, kp; };
struct Gemm { const bf16_t* A; const bf16_t* Bt; int lda, ldb, K; };

struct StaticOrder {
    int nM, nN, nwg, G, c;
    __host__ __device__ void init(int M, int N, int G_, int c_) { nM = M / BM; nN = N / BM; nwg = nM * nN; G = G_; c = c_; }
    __host__ __device__ bool map(long L, Unit& u) const {
        if (L >= nwg) return false;
        int wgid = (int)L; { const int q = nwg / NXCD, r = nwg % NXCD, xcd = wgid % NXCD, off = wgid / NXCD; wgid = (xcd < r ? xcd * (q + 1) : r * (q + 1) + (xcd - r) * q) + off; }
        const int nig = WGM * nN, gid = wgid / nig, fm = gid * WGM, gsz = (nM - fm) < WGM ? (nM - fm) : WGM;
        u.pm = fm + ((wgid % nig) % gsz); u.pn = (wgid % nig) / gsz; u.kp = 0; return true;
    }
    __host__ __device__ bool next(int i, Unit& u) const { return map((long)i * G + c, u); }
};
struct PairOrder {
    StaticOrder b;
    __host__ __device__ bool next(int i, Unit& u) const { if (!b.map((long)(i >> 1) * b.G + b.c, u)) return false; u.kp = i & 1; return true; }
};

__device__ __forceinline__ unsigned cvt_pk_bf16(float lo, float hi) { unsigned r; asm volatile("v_cvt_pk_bf16_f32 %0, %1, %2" : "=v"(r) : "v"(lo), "v"(hi)); return r; }

template <class Epi, class Sched, bool ALIGN_EPI>
__device__ __forceinline__ void gemm_phase(PG8_LAS unsigned char* lds, const Gemm g, const Sched& S, const Epi& E) {
    const int tid = threadIdx.x, wid = __builtin_amdgcn_readfirstlane(tid >> 6), lane = tid & 63, wr = wid >> 2, wc = wid & 3, fr = lane & 15, fq = lane >> 4;
    const int K = g.K, nt = K / BK;
    unsigned voffA[2], voffB[2];
#pragma unroll
    for (int i = 0; i < 2; ++i) { int R, C; stage_rc(tid * 16 + i * 8192, R, C); const int Rb = Epi::PERM ? ((R & ~31) + perm32(R & 31)) : R;
        voffA[i] = (unsigned)(R * g.lda + C) * 2u; voffB[i] = (unsigned)(Rb * g.ldb + C) * 2u; }
    const size_t kstep = (size_t)(BK * 2);
    const size_t hstepA = (size_t)HALF * g.lda * 2, hstepB = (size_t)HALF * g.ldb * 2;
    const size_t tstepA = 2 * hstepA, tstepB = 2 * hstepB;
    const unsigned ldsw = (unsigned)wid * 1024u;
    const int aoff = lds_byte(wr * 64 + fr, fq * 8), boff = lds_byte(wc * 32 + fr, fq * 8);
#define PG8_SA(b, h) (((b) * 2 + (h)) * HTB)
#define PG8_SB(b, h) ((4 + (b) * 2 + (h)) * HTB)
#define PG8_STAGE(bufoff, gbase, voff) do { _Pragma("unroll") for (int _i = 0; _i < 2; ++_i) \
        __builtin_amdgcn_global_load_lds((const unsigned*)((const char*)(gbase) + (voff)[_i]), (PG8_LAS unsigned*)(lds + (bufoff) + ldsw + _i * 8192), 16, 0, 0); } while (0)
#define PG8_LDA(dst, b, h) do { _Pragma("unroll") for (int m = 0; m < 4; ++m) _Pragma("unroll") for (int k = 0; k < 2; ++k) dst[m][k] = *(const PG8_LAS bf16x8*)(lds + PG8_SA(b, h) + aoff + m * 2048 + k * 1024); } while (0)
#define PG8_LDB(dst, b, h) do { _Pragma("unroll") for (int n = 0; n < 2; ++n) _Pragma("unroll") for (int k = 0; k < 2; ++k) dst[n][k] = *(const PG8_LAS bf16x8*)(lds + PG8_SB(b, h) + boff + n * 2048 + k * 1024); } while (0)
#define PG8_MMA(ai, bj, At, Bt) do { __builtin_amdgcn_s_setprio(1); _Pragma("unroll") for (int m = 0; m < 4; ++m) _Pragma("unroll") for (int n = 0; n < 2; ++n) _Pragma("unroll") for (int k = 0; k < 2; ++k) \
        acc[ai][bj][m][n] = __builtin_amdgcn_mfma_f32_16x16x32_bf16(Bt[n][k], At[m][k], acc[ai][bj][m][n], 0, 0, 0); __builtin_amdgcn_s_setprio(0); } while (0)
#define PG8_WAIT_V(n) asm volatile("s_waitcnt vmcnt(" #n ")" ::: "memory")
#define PG8_WAIT_L(n) asm volatile("s_waitcnt lgkmcnt(" #n ")" ::: "memory")
#define PG8_BAR __builtin_amdgcn_s_barrier()
#define PG8_SCHED __builtin_amdgcn_sched_barrier(0)
    Unit cur, nxt; int ui = 0;
    if (!S.next(0, cur)) return;
    f32x4 acc[2][2][4][2];
#pragma unroll
    for (int a = 0; a < 2; ++a)
#pragma unroll
        for (int b = 0; b < 2; ++b)
#pragma unroll
            for (int m = 0; m < 4; ++m)
#pragma unroll
                for (int n = 0; n < 2; ++n) acc[a][b][m][n] = (f32x4){0.f, 0.f, 0.f, 0.f};
    bf16x8 At[4][2], B0[2][2], B1[2][2];
    const char* cA = (const char*)g.A + (size_t)cur.pm * tstepA + (size_t)cur.kp * K * 2; const char* cB = (const char*)g.Bt + (size_t)cur.pn * tstepB + (size_t)cur.kp * K * 2;
    PG8_STAGE(PG8_SB(0, 0), cB, voffB); PG8_STAGE(PG8_SB(0, 1), cB + hstepB, voffB); PG8_STAGE(PG8_SA(0, 0), cA, voffA); PG8_STAGE(PG8_SA(0, 1), cA + hstepA, voffA);
    if (wr == 1) PG8_BAR;
    PG8_WAIT_V(2); PG8_BAR;
    PG8_STAGE(PG8_SB(1, 0), cB + kstep, voffB); PG8_STAGE(PG8_SA(1, 0), cA + kstep, voffA); PG8_STAGE(PG8_SB(1, 1), cB + hstepB + kstep, voffB);
    PG8_WAIT_V(6); PG8_BAR;
    for (;;) {
        const bool has_next = S.next(ui + 1, nxt);
        const char* nA = has_next ? (const char*)g.A + (size_t)nxt.pm * tstepA + (size_t)nxt.kp * K * 2 : cA; const char* nB = has_next ? (const char*)g.Bt + (size_t)nxt.pn * tstepB + (size_t)nxt.kp * K * 2 : cB;
        for (int t = 0; t < nt; t += 2) {
            const bool last = (t == nt - 2);
            const char* a1 = cA + (size_t)(t + 1) * kstep;
            const char* a2 = last ? nA : cA + (size_t)(t + 2) * kstep; const char* b2 = last ? nB : cB + (size_t)(t + 2) * kstep;
            const char* a3 = a2 + kstep; const char* b3 = b2 + kstep;
            PG8_LDB(B0, 0, 0); PG8_LDB(B1, 0, 1); PG8_SCHED; PG8_LDA(At, 0, 0); PG8_STAGE(PG8_SA(1, 1), a1 + hstepA, voffA);
            PG8_WAIT_V(8); PG8_WAIT_L(0); PG8_BAR; PG8_MMA(0, 0, At, B0); PG8_MMA(0, 1, At, B1); PG8_BAR; PG8_SCHED;
            PG8_LDA(At, 0, 1); PG8_STAGE(PG8_SB(0, 0), b2, voffB); PG8_STAGE(PG8_SB(0, 1), b2 + hstepB, voffB); PG8_STAGE(PG8_SA(0, 0), a2, voffA);
            PG8_WAIT_V(8); PG8_WAIT_L(0); PG8_BAR; PG8_MMA(1, 0, At, B0); PG8_MMA(1, 1, At, B1); PG8_BAR; PG8_SCHED;
            PG8_LDB(B0, 1, 0); PG8_LDB(B1, 1, 1); PG8_SCHED; PG8_LDA(At, 1, 0); PG8_STAGE(PG8_SA(0, 1), a2 + hstepA, voffA);
            PG8_WAIT_V(8); PG8_WAIT_L(0); PG8_BAR; PG8_MMA(0, 0, At, B0); PG8_MMA(0, 1, At, B1); PG8_BAR; PG8_SCHED;
            PG8_LDA(At, 1, 1); PG8_STAGE(PG8_SB(1, 0), b3, voffB); PG8_STAGE(PG8_SB(1, 1), b3 + hstepB, voffB); PG8_STAGE(PG8_SA(1, 0), a3, voffA);
            PG8_WAIT_V(8); PG8_WAIT_L(0); PG8_BAR; PG8_MMA(1, 0, At, B0); PG8_MMA(1, 1, At, B1); PG8_BAR; PG8_SCHED;
        }
        if constexpr (ALIGN_EPI) { if (wr == 0) PG8_BAR; }
        const bool keep = E(acc, cur, wr, wc, fr, fq);
        if (!has_next) break;
        if (!keep) {
#pragma unroll
        for (int a = 0; a < 2; ++a)
#pragma unroll
            for (int b = 0; b < 2; ++b)
#pragma unroll
                for (int m = 0; m < 4; ++m)
#pragma unroll
                    for (int n = 0; n < 2; ++n) acc[a][b][m][n] = (f32x4){0.f, 0.f, 0.f, 0.f};
        }
        cur = nxt; cA = nA; cB = nB; ++ui;
        if constexpr (ALIGN_EPI) { if (wr == 1) PG8_BAR; }
    }
    PG8_WAIT_V(0);
    if constexpr (!ALIGN_EPI) { if (wr == 0) PG8_BAR; }
    PG8_BAR;
#undef PG8_SA
#undef PG8_SB
#undef PG8_STAGE
#undef PG8_LDA
#undef PG8_LDB
#undef PG8_MMA
#undef PG8_WAIT_V
#undef PG8_WAIT_L
#undef PG8_BAR
#undef PG8_SCHED
}
}

constexpr int NWAVES = 8;
constexpr int N_LAUNCHES = MK_N_LAUNCHES;
constexpr int PER_PHASE = 5;
constexpr int DM = 1024, SEQ = 2048, NB = 32, DSEQ = 64, PAST = 4096, NH = 8, INC = 8192;
constexpr int MP = NB * SEQ;
constexpr int MS = NB * DSEQ;
constexpr int MR = MP + MS;
constexpr float EPS = 1e-6f, LOG2E = 1.4426950408889634f;
constexpr float QSCALE = 0.125f * LOG2E;
constexpr float LAM_INIT = 0.2f;
constexpr size_t O_YP = 0, O_YS = 67108864, O_KP = 69206016, O_VP = 136314880, O_CP = 203423744, O_LP = 203522048,
                 O_KS = 203554816, O_VS = 205651968, O_CS = 207749120, O_LS = 207847424, O_END = 207880192;
constexpr size_t MiB = 1u << 20;
constexpr size_t ACT = (size_t)MR * DM * 2;
constexpr size_t WS_CTL = 0, CTL_ZERO_BYTES = 1 * MiB;
constexpr size_t WS_WIN = 2 * MiB, WS_WAB = 18 * MiB, WS_WOUT = 22 * MiB, WS_WG = 24 * MiB;
constexpr size_t WS_XN = 32 * MiB;
constexpr size_t WS_XA = WS_XN + ACT, WS_ZA = WS_XA + ACT, WS_Q = WS_ZA + ACT, WS_K = WS_Q + ACT, WS_V = WS_K + ACT, WS_ZB = WS_V + ACT, WS_GA = WS_ZB + ACT, WS_GB = WS_GA + ACT;
constexpr size_t WS_YAB = WS_GB + ACT;
constexpr size_t WS_END = WS_YAB + 2 * ACT;
constexpr int CW_TMO = 0, CW_BAR = 4096;

constexpr int RING_OFF = 0, RING_BYTES = 131072;
constexpr int LDSCTL_OFF = RING_BYTES, MISC_OFF = LDSCTL_OFF + 320;
constexpr int LDS_BYTES = 147456;

#define GAS __attribute__((address_space(1)))
#define LAS __attribute__((address_space(3)))
typedef unsigned short bf16;
typedef unsigned v4u __attribute__((ext_vector_type(4)));
typedef float f32x4 __attribute__((ext_vector_type(4)));
typedef float f32x8 __attribute__((ext_vector_type(8)));
typedef float f32x16 __attribute__((ext_vector_type(16)));
typedef short bf16x8 __attribute__((ext_vector_type(8)));
typedef short s16x4 __attribute__((ext_vector_type(4)));
typedef GAS unsigned gu32;
#define RLX_AGENT __ATOMIC_RELAXED, __HIP_MEMORY_SCOPE_AGENT
#define LDS_WAIT() asm volatile("s_waitcnt lgkmcnt(0)" ::: "memory")
#define VM_WAIT() asm volatile("s_waitcnt vmcnt(0)" ::: "memory")
__device__ __forceinline__ unsigned pk2(float lo, float hi) { return pg8::cvt_pk_bf16(lo, hi); }
__device__ __forceinline__ float bf2f(unsigned short v) { return __builtin_bit_cast(float, (unsigned)v << 16); }
__device__ __forceinline__ float bflo(unsigned w) { return __builtin_bit_cast(float, w << 16); }
__device__ __forceinline__ float bfhi(unsigned w) { return __builtin_bit_cast(float, w & 0xffff0000u); }
__device__ __forceinline__ float sigm(float v) { return __builtin_amdgcn_rcpf(1.f + __builtin_amdgcn_exp2f(-LOG2E * v)); }

#define XB_TMO      128
#define XB_XCNT(j)  (256  + 64 * (j))
#define XB_XSUB(j)  (1280 + 64 * (j))
#define XB_XGEN(j)  (2304 + 64 * (j))
#define XB_TOP      3328
#define XB_TOPGEN   3392
#define XCD_BAR_WORDS 3456
#define XB_SPIN_CAP (1u << 18)
__device__ __forceinline__ unsigned xb_ld(unsigned* p)              { return __hip_atomic_load(p, __ATOMIC_RELAXED, __HIP_MEMORY_SCOPE_AGENT); }
__device__ __forceinline__ unsigned xb_add(unsigned* p, unsigned v) { return __hip_atomic_fetch_add(p, v, __ATOMIC_RELAXED, __HIP_MEMORY_SCOPE_AGENT); }
__device__ __forceinline__ unsigned xb_xcc_id() { return (unsigned)__builtin_amdgcn_s_getreg((3 << 11) | 20) & 0xFu; }
#define XB_SPIN(cond, bar) do { unsigned _sp = 0; while (cond) { __builtin_amdgcn_s_sleep(1); \
    if ((++_sp & 255u) == 0u) { if (xb_ld(&(bar)[XB_TMO])) break; if (_sp > XB_SPIN_CAP) { atomicAdd(&(bar)[XB_TMO], 1u); break; } } } } while (0)
struct XcdBarrier { unsigned* bar; unsigned x; volatile LAS unsigned* st; };
__device__ __forceinline__ XcdBarrier xcd_barrier_post(unsigned* bar, volatile LAS unsigned* st) {
    XcdBarrier b; b.bar = bar; b.x = xb_xcc_id(); b.st = st;
    if (threadIdx.x == 0) (void)xb_add(&bar[XB_XCNT(b.x)], 1u);
    return b;
}
__device__ __forceinline__ void xcd_barrier_complete(unsigned* bar, unsigned x, unsigned& nloc, unsigned& nx) {
    const unsigned G = gridDim.x * gridDim.y * gridDim.z;
    unsigned sum, cnt, mine, sp = 0u;
    for (;;) {
        sum = 0u; cnt = 0u; mine = 0u;
#pragma unroll
        for (unsigned j = 0; j < 16; ++j) { const unsigned c = xb_ld(&bar[XB_XCNT(j)]); sum += c; cnt += (c > 0u) ? 1u : 0u; mine = (j == x) ? c : mine; }
        if (sum == G) break;
        __builtin_amdgcn_s_sleep(1);
        if ((++sp & 255u) == 0u) { if (xb_ld(&bar[XB_TMO])) break; if (sp > XB_SPIN_CAP) { atomicAdd(&bar[XB_TMO], 1u); break; } }
    }
    nloc = mine > 0u ? mine : 1u; nx = cnt > 0u ? cnt : 1u;
}
__device__ __forceinline__ void xcd_barrier(const XcdBarrier& b) {
    asm volatile("s_waitcnt vmcnt(0)" ::: "memory");
    __syncthreads();
    if (threadIdx.x == 0) {
        unsigned* bar = b.bar;
        __builtin_amdgcn_s_waitcnt(0);
        unsigned nloc = b.st[0], nx = b.st[1];
        if (nloc == 0u) { xcd_barrier_complete(bar, b.x, nloc, nx); b.st[0] = nloc; b.st[1] = nx; }
        const unsigned old = xb_add(&bar[XB_XSUB(b.x)], 1u);
        const unsigned gen = old / nloc;
        if (old + 1u == (gen + 1u) * nloc) {
            __builtin_amdgcn_fence(__ATOMIC_RELEASE, "agent");
            asm volatile("s_waitcnt vmcnt(0)" ::: "memory");
            const unsigned og = xb_add(&bar[XB_TOP], 1u);
            const unsigned tg = og / nx;
            if (og + 1u == (tg + 1u) * nx) xb_add(&bar[XB_TOPGEN], 1u);
            else XB_SPIN(xb_ld(&bar[XB_TOPGEN]) == tg, bar);
            __builtin_amdgcn_fence(__ATOMIC_ACQUIRE, "agent");
            xb_add(&bar[XB_XGEN(b.x)], 1u);
            asm volatile("s_waitcnt vmcnt(0)" ::: "memory");
        } else {
            XB_SPIN(xb_ld(&bar[XB_XGEN(b.x)]) == gen, bar);
            __builtin_amdgcn_fence(__ATOMIC_ACQUIRE, "agent");
            asm volatile("s_waitcnt vmcnt(0)" ::: "memory");
        }
    }
    __syncthreads();
}

struct Frame {
    LAS unsigned char* lds;
    volatile LAS unsigned* MISC;
    gu32* ctl;
    int tid, lane, wave;
    int vcu, G;
    const float* in[26]; float* out; unsigned char* ws;
};
__device__ __forceinline__ float wave_sum(float v) {
#pragma unroll
    for (int o = 1; o < 64; o <<= 1) v += __shfl_xor(v, o);
    return v;
}
__device__ __forceinline__ float wave_max(float v) {
#pragma unroll
    for (int o = 1; o < 64; o <<= 1) v = fmaxf(v, __shfl_xor(v, o));
    return v;
}

__device__ __forceinline__ void p0_transpose_item(const float* W, int ldw, int k0, int n0, bf16* WT, int ldt, int trow0, int tcol0, LAS float* scr, int lane) {
#pragma unroll 8
    for (int i = 0; i < 32; ++i) { const int kk = 2 * i + (lane >> 5); scr[kk * 33 + (lane & 31)] = W[(size_t)(k0 + kk) * ldw + n0 + (lane & 31)]; }
    LDS_WAIT(); asm volatile("" ::: "memory");
    const int c = lane & 7;
#pragma unroll
    for (int j = 0; j < 4; ++j) { const int n = (lane >> 3) + 8 * j; const LAS float* s = scr + (8 * c) * 33 + n;
        v4u o; o.x = pk2(s[0 * 33], s[1 * 33]); o.y = pk2(s[2 * 33], s[3 * 33]); o.z = pk2(s[4 * 33], s[5 * 33]); o.w = pk2(s[6 * 33], s[7 * 33]);
        *(GAS v4u*)(WT + (size_t)(trow0 + n) * ldt + tcol0 + 8 * c) = o; }
    LDS_WAIT(); asm volatile("" ::: "memory");
}
__device__ __forceinline__ void rms_row_to_bf16(const float* xrow, const float* gain, bf16* orow, int lane) {
    const GAS f32x4* xr = (const GAS f32x4*)xrow + lane; const GAS f32x4* gr = (const GAS f32x4*)gain + lane;
    f32x4 v[4]; float s = 0.f;
#pragma unroll
    for (int j = 0; j < 4; ++j) { v[j] = xr[64 * j]; s += (v[j].x * v[j].x + v[j].y * v[j].y) + (v[j].z * v[j].z + v[j].w * v[j].w); }
    const float rinv = 1.f / sqrtf(wave_sum(s) * (1.f / DM) + EPS);
    GAS unsigned long long* o8 = (GAS unsigned long long*)orow + lane;
#pragma unroll
    for (int j = 0; j < 4; ++j) { const f32x4 g = gr[64 * j];
        o8[64 * j] = (unsigned long long)pk2(v[j].x * rinv * g.x, v[j].y * rinv * g.y) | ((unsigned long long)pk2(v[j].z * rinv * g.z, v[j].w * rinv * g.w) << 32); }
}
__device__ __forceinline__ void p0_prologue(Frame& F) {
    LAS float* scr = (LAS float*)(F.lds + RING_OFF + F.wave * 16384);
    const int gw = F.vcu * NWAVES + F.wave, NGW = F.G * NWAVES;
    bf16* WIN = (bf16*)(F.ws + WS_WIN); bf16* WAB = (bf16*)(F.ws + WS_WAB); bf16* WOUT = (bf16*)(F.ws + WS_WOUT); bf16* WG = (bf16*)(F.ws + WS_WG);
    constexpr int I_IN = 16 * 256, I_P = 16 * 32, I_G = 16 * 2 * 4;
    constexpr int NITEMS = I_IN + 3 * I_P + I_G;
    for (int it = gw; it < NITEMS; it += NGW) {
        int r = it;
        if (r < I_IN) { const int kb = r / 256, nb = r % 256, n0 = nb * 32; const int within = n0 & 255, wc = within >> 6, bj = (within >> 5) & 1;
            p0_transpose_item(F.in[7], INC, kb * 64, n0, WIN, DM, (n0 & ~255) + bj * 128 + wc * 32, kb * 64, scr, F.lane); continue; } r -= I_IN;
        if (r < I_P) { const int kb = r / 32, nb = r % 32; p0_transpose_item(F.in[23], DM, kb * 64, nb * 32, WAB, 2 * DM, nb * 32, kb * 64, scr, F.lane); continue; } r -= I_P;
        if (r < I_P) { const int kb = r / 32, nb = r % 32; p0_transpose_item(F.in[24], DM, kb * 64, nb * 32, WAB, 2 * DM, nb * 32, DM + kb * 64, scr, F.lane); continue; } r -= I_P;
        if (r < I_P) { const int kb = r / 32, nb = r % 32; p0_transpose_item(F.in[25], DM, kb * 64, nb * 32, WOUT, DM, nb * 32, kb * 64, scr, F.lane); continue; } r -= I_P;
        { const int blk = r / 8, sub = r % 8, kb = sub / 4, nb = sub % 4, n = blk >> 1, g = blk & 1;
          p0_transpose_item((g ? F.in[12] : F.in[10]) + (size_t)n * 16384, 128, kb * 64, nb * 32, WG + (size_t)blk * 16384, 128, nb * 32, kb * 64, scr, F.lane); }
    }
    bf16* XN = (bf16*)(F.ws + WS_XN);
    for (int m = gw; m < MR; m += NGW) {
        const float* xr = (m < MP) ? F.in[0] + (size_t)m * DM : F.in[1] + (size_t)(m - MP) * DM;
        rms_row_to_bf16(xr, F.in[6], XN + (size_t)m * DM, F.lane);
    }
}

__device__ __forceinline__ v4u pack8(const float* v) { v4u w; w.x = pk2(v[0], v[1]); w.y = pk2(v[2], v[3]); w.z = pk2(v[4], v[5]); w.w = pk2(v[6], v[7]); return w; }
struct EpiIn {
    static constexpr bool PERM = true;
    unsigned char* ws; float* out; const float* qg; const float* kg;
    __device__ __forceinline__ bool operator()(pg8::f32x4 (&acc)[2][2][4][2], const pg8::Unit& u, int wr, int wc, int fr, int fq) const {
        const int g = u.pn >> 2;
        const int cb = (u.pn & 3) * 256 + wc * 64 + fq * 8;
        const int row0 = u.pm * 256 + wr * 64 + fr;
        const bool smp = u.pm >= 256;
        if (g == 2 || g == 3) {
            const float* gn = (g == 2) ? qg : kg; const float sc = (g == 2) ? QSCALE : 1.f;
            float gv[2][8];
#pragma unroll
            for (int bj = 0; bj < 2; ++bj)
#pragma unroll
                for (int e = 0; e < 8; ++e) gv[bj][e] = gn[bj * 32 + fq * 8 + e] * sc;
            bf16* dstb = (bf16*)(ws + (g == 2 ? WS_Q : WS_K));
            float* kout = smp ? out + O_KS - (size_t)MP * DM : out + O_KP;
#pragma unroll
            for (int ai = 0; ai < 2; ++ai)
#pragma unroll
                for (int m = 0; m < 4; ++m) {
                    const size_t row = (size_t)(row0 + ai * 128 + m * 16);
                    float ss = 0.f;
#pragma unroll
                    for (int bj = 0; bj < 2; ++bj)
#pragma unroll
                        for (int n = 0; n < 2; ++n) { const pg8::f32x4 a = acc[ai][bj][m][n]; ss += (a.x * a.x + a.y * a.y) + (a.z * a.z + a.w * a.w); }
                    ss += __shfl_xor(ss, 16); ss += __shfl_xor(ss, 32);
                    const float rinv = 1.f / sqrtf(ss * (1.f / 64.f) + EPS);
#pragma unroll
                    for (int bj = 0; bj < 2; ++bj) {
                        float v[8];
#pragma unroll
                        for (int e = 0; e < 8; ++e) v[e] = acc[ai][bj][m][e >> 2][e & 3] * rinv * gv[bj][e];
                        *(GAS v4u*)(dstb + row * DM + cb + bj * 32) = pack8(v);
                        if (g == 3) { GAS f32x4* o = (GAS f32x4*)(kout + row * DM + cb + bj * 32); o[0] = (f32x4){v[0], v[1], v[2], v[3]}; o[1] = (f32x4){v[4], v[5], v[6], v[7]}; }
                    }
                }
            return false;
        }
        bf16* dstb = (bf16*)(ws + (g == 0 ? WS_XA : g == 1 ? WS_ZA : g == 4 ? WS_V : g == 5 ? WS_ZB : g == 6 ? WS_GA : WS_GB));
        float* vout = smp ? out + O_VS - (size_t)MP * DM : out + O_VP;
#pragma unroll
        for (int ai = 0; ai < 2; ++ai)
#pragma unroll
            for (int m = 0; m < 4; ++m) {
                const int rowi = row0 + ai * 128 + m * 16; const size_t row = (size_t)rowi;
#pragma unroll
                for (int bj = 0; bj < 2; ++bj) {
                    float v[8];
#pragma unroll
                    for (int e = 0; e < 8; ++e) v[e] = acc[ai][bj][m][e >> 2][e & 3];
                    if (g == 0) {
                        const int t = smp ? (rowi & 63) : (rowi & 2047); const int T = smp ? 64 : 2048;
                        if (t >= T - 3) { const int b = smp ? ((rowi - MP) >> 6) : (rowi >> 11);
                            GAS f32x4* o = (GAS f32x4*)(out + (smp ? O_CS : O_CP) + (size_t)(b * 3 + (t - (T - 3))) * DM + cb + bj * 32);
                            o[0] = (f32x4){v[0], v[1], v[2], v[3]}; o[1] = (f32x4){v[4], v[5], v[6], v[7]}; }
                    } else if (g == 4) {
                        GAS f32x4* o = (GAS f32x4*)(vout + row * DM + cb + bj * 32); o[0] = (f32x4){v[0], v[1], v[2], v[3]}; o[1] = (f32x4){v[4], v[5], v[6], v[7]};
                    } else if (g == 1 || g == 5) {
#pragma unroll
                        for (int e = 0; e < 8; ++e) v[e] = v[e] * sigm(v[e]);
                    } else if (g == 6 || g == 7) {
#pragma unroll
                        for (int e = 0; e < 8; ++e) v[e] = sigm(v[e]);
                    }
                    *(GAS v4u*)(dstb + row * DM + cb + bj * 32) = pack8(v);
                }
            }
        return false;
    }
};
struct EpiProj {
    static constexpr bool PERM = true;
    const bf16* GA; const bf16* GB; bf16* MB;
    __device__ __forceinline__ bool operator()(pg8::f32x4 (&acc)[2][2][4][2], const pg8::Unit& u, int wr, int wc, int fr, int fq) const {
        const int row0 = u.pm * 256 + wr * 64 + fr, col0 = u.pn * 256 + wc * 32 + 8 * fq;
#pragma unroll
        for (int ai = 0; ai < 2; ++ai)
#pragma unroll
            for (int m = 0; m < 4; ++m) {
                const size_t row = (size_t)(row0 + ai * 128 + m * 16);
#pragma unroll
                for (int bj = 0; bj < 2; ++bj) {
                    const size_t off = row * DM + col0 + bj * 128;
                    const v4u gb = *(const GAS v4u*)(GB + off);
                    float b[8] = {bflo(gb.x), bfhi(gb.x), bflo(gb.y), bfhi(gb.y), bflo(gb.z), bfhi(gb.z), bflo(gb.w), bfhi(gb.w)};
                    if (u.kp == 0) {
                        const v4u ga = *(const GAS v4u*)(GA + off);
                        float a[8] = {bflo(ga.x), bfhi(ga.x), bflo(ga.y), bfhi(ga.y), bflo(ga.z), bfhi(ga.z), bflo(ga.w), bfhi(ga.w)};
#pragma unroll
                        for (int e = 0; e < 8; ++e) acc[ai][bj][m][e >> 2][e & 3] *= a[e] * __builtin_amdgcn_rcpf(fmaxf(b[e], 1e-20f));
                    } else {
                        float v[8];
#pragma unroll
                        for (int e = 0; e < 8; ++e) v[e] = acc[ai][bj][m][e >> 2][e & 3] * b[e];
                        *(GAS v4u*)(MB + off) = pack8(v);
                    }
                }
            }
        return u.kp == 0;
    }
};
struct EpiOut {
    static constexpr bool PERM = false;
    const float* xp; const float* xs; float* out;
    __device__ __forceinline__ bool operator()(pg8::f32x4 (&acc)[2][2][4][2], const pg8::Unit& u, int wr, int wc, int fr, int fq) const {
        const int row0 = u.pm * 256 + wr * 64 + fr, col0 = u.pn * 256 + wc * 32 + 4 * fq;
        const float* xb = (u.pm >= 256) ? xs - (size_t)MP * DM : xp;
#pragma unroll
        for (int ai = 0; ai < 2; ++ai)
#pragma unroll
            for (int m = 0; m < 4; ++m) {
                const size_t row = (size_t)(row0 + ai * 128 + m * 16);
#pragma unroll
                for (int bj = 0; bj < 2; ++bj)
#pragma unroll
                    for (int n = 0; n < 2; ++n) { const size_t off = row * DM + col0 + bj * 128 + n * 16;
                        const f32x4 xv = *(const GAS f32x4*)(xb + off); const pg8::f32x4 a = acc[ai][bj][m][n];
                        *(GAS f32x4*)(out + off) = (f32x4){xv.x + a.x, xv.y + a.y, xv.z + a.z, xv.w + a.w}; }
            }
        return false;
    }
};

constexpr int L_XCB = 0, L_XCF = 17408, L_AA = L_XCF + 33792, L_BB = L_AA + 33792, L_SEG = L_BB + 33792, L_HP = L_SEG + 4096;
static_assert(L_HP + 1024 <= RING_BYTES, "LRU LDS map");
__device__ __forceinline__ void lru_unit(Frame& F, int seq, int n) {
    const bool smp = seq >= 32; const int b = smp ? seq - 32 : seq; const int T = smp ? DSEQ : SEQ;
    const size_t rowbase = smp ? (size_t)MP + (size_t)b * DSEQ : (size_t)b * SEQ;
    const int tid = F.tid, lane = F.lane, w = F.wave;
    LAS unsigned char* L = F.lds;
    LAS bf16* XCB = (LAS bf16*)(L + L_XCB); LAS float* XCF = (LAS float*)(L + L_XCF); LAS float* AA = (LAS float*)(L + L_AA); LAS float* BB = (LAS float*)(L + L_BB);
    LAS float* SEGA = (LAS float*)(L + L_SEG); LAS float* SEGB = SEGA + 512; LAS float* HP = (LAS float*)(L + L_HP);
    const bf16* XA = (const bf16*)(F.ws + WS_XA); const bf16* ZA = (const bf16*)(F.ws + WS_ZA); bf16* YAB = (bf16*)(F.ws + WS_YAB);
    const int ct = tid >> 4, cg = tid & 15, c0 = 128 * n + 8 * cg;
    float cw[4][8], cbias[8];
#pragma unroll
    for (int e = 0; e < 8; ++e) { cbias[e] = F.in[9][c0 + e];
#pragma unroll
        for (int j = 0; j < 4; ++j) cw[j][e] = F.in[8][j * DM + c0 + e]; }
    const int dl = 16 * w + (lane & 15), tq = lane >> 4, dg = 128 * n + dl;
    const float brg = F.in[11][dg], big = F.in[13][dg];
    float sp; { const float x = -F.in[14][dg]; sp = fmaxf(x, 0.f) + log1pf(expf(-fabsf(x))); }
    bf16x8 Br[4], Bi[4];
    { const bf16* WG = (const bf16*)(F.ws + WS_WG) + (size_t)(2 * n) * 16384;
#pragma unroll
      for (int kk = 0; kk < 4; ++kk) { Br[kk] = *(const GAS bf16x8*)(WG + (size_t)dl * 128 + 32 * kk + 8 * tq); Bi[kk] = *(const GAS bf16x8*)(WG + 16384 + (size_t)dl * 128 + 32 * kk + 8 * tq); } }
    const int ch = tid & 127, sg = tid >> 7;
    if (tid < 128) HP[tid] = smp ? F.in[5][b * DM + 128 * n + tid] : 0.f;
    float hlast = 0.f; int cur = 0;
    for (int t0 = 0; t0 < T; t0 += 64, cur ^= 1) {
#pragma unroll
        for (int p = 0; p < 2; ++p) {
            const int t = ct + 32 * p, tg = t0 + t;
            float a[8];
#pragma unroll
            for (int e = 0; e < 8; ++e) a[e] = cbias[e];
#pragma unroll
            for (int j = 0; j < 4; ++j) {
                const int i = tg + j;
                float x[8];
                if (i >= 3) { const v4u q = *(const GAS v4u*)(XA + (rowbase + i - 3) * DM + c0);
                    x[0] = bflo(q.x); x[1] = bfhi(q.x); x[2] = bflo(q.y); x[3] = bfhi(q.y); x[4] = bflo(q.z); x[5] = bfhi(q.z); x[6] = bflo(q.w); x[7] = bfhi(q.w); }
                else if (smp) { const GAS f32x4* s = (const GAS f32x4*)(F.in[4] + (size_t)(b * 3 + i) * DM + c0); const f32x4 s0 = s[0], s1 = s[1];
                    x[0] = s0.x; x[1] = s0.y; x[2] = s0.z; x[3] = s0.w; x[4] = s1.x; x[5] = s1.y; x[6] = s1.z; x[7] = s1.w; }
                else {
#pragma unroll
                    for (int e = 0; e < 8; ++e) x[e] = 0.f; }
#pragma unroll
                for (int e = 0; e < 8; ++e) a[e] += x[e] * cw[j][e];
            }
            *(LAS f32x4*)(XCF + t * 132 + 8 * cg) = (f32x4){a[0], a[1], a[2], a[3]}; *(LAS f32x4*)(XCF + t * 132 + 8 * cg + 4) = (f32x4){a[4], a[5], a[6], a[7]};
            *(LAS v4u*)(XCB + t * 136 + 8 * cg) = pack8(a);
        }
        __syncthreads();
        {
            pg8::f32x4 ar[4], ai_[4];
#pragma unroll
            for (int tt = 0; tt < 4; ++tt) { ar[tt] = (pg8::f32x4){0.f, 0.f, 0.f, 0.f}; ai_[tt] = (pg8::f32x4){0.f, 0.f, 0.f, 0.f}; }
#pragma unroll
            for (int tt = 0; tt < 4; ++tt)
#pragma unroll
                for (int kk = 0; kk < 4; ++kk) {
                    const bf16x8 af = *(const LAS bf16x8*)(XCB + (16 * tt + (lane & 15)) * 136 + 32 * kk + 8 * tq);
                    ar[tt] = __builtin_amdgcn_mfma_f32_16x16x32_bf16(af, Br[kk], ar[tt], 0, 0, 0);
                    ai_[tt] = __builtin_amdgcn_mfma_f32_16x16x32_bf16(af, Bi[kk], ai_[tt], 0, 0, 0);
                }
#pragma unroll
            for (int tt = 0; tt < 4; ++tt)
#pragma unroll
                for (int rg = 0; rg < 4; ++rg) {
                    const int t = 16 * tt + 4 * tq + rg;
                    const float r = sigm(ar[tt][rg] + brg), ig = sigm(ai_[tt][rg] + big);
                    const float la = -8.f * r * sp;
                    const float av = __builtin_amdgcn_exp2f(la * LOG2E);
                    const float x2 = 2.f * la;
                    float em = (x2 > -0.06f) ? -x2 * (1.f + x2 * (0.5f + x2 * (0.16666667f + x2 * 0.041666668f))) : 1.f - __builtin_amdgcn_exp2f(x2 * LOG2E);
                    float mult = sqrtf(em);
                    if (!smp && (t0 + t) == 0) mult = 1.f;
                    AA[t * 132 + dl] = av; BB[t * 132 + dl] = mult * ig * XCF[t * 132 + dl];
                }
        }
        __syncthreads();
        {
            float Ac = 1.f, Bc = 0.f;
#pragma unroll
            for (int i = 0; i < 16; ++i) { const int t = 16 * sg + i; const float av = AA[t * 132 + ch], bv = BB[t * 132 + ch]; Bc = av * Bc + bv; Ac *= av; }
            SEGA[sg * 128 + ch] = Ac; SEGB[sg * 128 + ch] = Bc;
        }
        __syncthreads();
        {
            float h = HP[cur * 128 + ch];
            for (int s = 0; s < sg; ++s) h = SEGA[s * 128 + ch] * h + SEGB[s * 128 + ch];
            const size_t r0 = rowbase + t0 + 16 * sg;
            unsigned short zv[16];
#pragma unroll
            for (int i = 0; i < 16; ++i) zv[i] = *(const GAS unsigned short*)(ZA + (r0 + i) * DM + 128 * n + ch);
#pragma unroll
            for (int i = 0; i < 16; ++i) { const int t = 16 * sg + i; h = AA[t * 132 + ch] * h + BB[t * 132 + ch];
                const float y = h * bf2f(zv[i]);
                *(GAS unsigned short*)(YAB + (r0 + i) * (2 * DM) + 128 * n + ch) = (unsigned short)(pk2(y, 0.f) & 0xffffu); }
            if (sg == 3) { HP[(cur ^ 1) * 128 + ch] = h; hlast = h; }
        }
    }
    if (sg == 3) F.out[(smp ? O_LS : O_LP) + (size_t)b * DM + 128 * n + ch] = hlast;
    __syncthreads();
}

#define KSWZ(row, colB) ((row) * 256 + ((colB) ^ (((row) & 7) << 4)))
#define SBAR() __builtin_amdgcn_sched_barrier(0)
constexpr int A_V = 0, A_K = 32768, A_TB = 65536, A_WS = 66560;
__device__ __forceinline__ int crow(int r, int hi) { return (r & 3) + 8 * (r >> 2) + 4 * hi; }
__device__ __forceinline__ int v_st(int k, int c) { const int kk = (k & ~0xC) | ((k & 4) << 1) | ((k & 8) >> 1); return ((kk >> 3) * 4 + (c >> 5)) * 512 + ((kk & 7) * 32 + (c & 31)) * 2; }
__device__ __forceinline__ int v_rd_base(int lane) { return ((lane & 3) << 3) | (((lane >> 2) & 3) << 6) | (((lane >> 4) & 1) << 5) | (((lane >> 5) & 1) << 8); }
constexpr int v_rd_off(int d0, int ks, int half) { return d0 * 512 + ks * 4096 + half * 2048; }
template <int OFF> __device__ __forceinline__ s16x4 tr_read(int vb) {
    s16x4 r; asm volatile("ds_read_b64_tr_b16 %0, %1 offset:%2" : "=&v"(r) : "v"(vb), "i"(OFF) : "memory"); return r;
}
#define PKV(L, H) (bf16x8){L[0], L[1], L[2], L[3], H[0], H[1], H[2], H[3]}
template <int D0, int NKS> __device__ __forceinline__ void pv_one(f32x16& od, int vb, bf16x8 pa0, bf16x8 pa1, bf16x8 pa2, bf16x8 pa3) {
    const s16x4 l0 = tr_read<v_rd_off(D0, 0, 0)>(vb), h0 = tr_read<v_rd_off(D0, 0, 1)>(vb), l1 = tr_read<v_rd_off(D0, 1, 0)>(vb), h1 = tr_read<v_rd_off(D0, 1, 1)>(vb);
    if constexpr (NKS == 4) {
        const s16x4 l2 = tr_read<v_rd_off(D0, 2, 0)>(vb), h2 = tr_read<v_rd_off(D0, 2, 1)>(vb), l3 = tr_read<v_rd_off(D0, 3, 0)>(vb), h3 = tr_read<v_rd_off(D0, 3, 1)>(vb);
        asm volatile("s_waitcnt lgkmcnt(0)" ::: "memory"); SBAR();
        od = __builtin_amdgcn_mfma_f32_32x32x16_bf16(pa0, PKV(l0, h0), od, 0, 0, 0);
        od = __builtin_amdgcn_mfma_f32_32x32x16_bf16(pa1, PKV(l1, h1), od, 0, 0, 0);
        od = __builtin_amdgcn_mfma_f32_32x32x16_bf16(pa2, PKV(l2, h2), od, 0, 0, 0);
        od = __builtin_amdgcn_mfma_f32_32x32x16_bf16(pa3, PKV(l3, h3), od, 0, 0, 0);
    } else {
        asm volatile("s_waitcnt lgkmcnt(0)" ::: "memory"); SBAR();
        od = __builtin_amdgcn_mfma_f32_32x32x16_bf16(pa0, PKV(l0, h0), od, 0, 0, 0);
        od = __builtin_amdgcn_mfma_f32_32x32x16_bf16(pa1, PKV(l1, h1), od, 0, 0, 0);
    }
}
__device__ __forceinline__ bf16x8 tobf8(f32x8 x) { v4u w = {pk2(x[0], x[1]), pk2(x[2], x[3]), pk2(x[4], x[5]), pk2(x[6], x[7])}; return __builtin_bit_cast(bf16x8, w); }
__device__ __forceinline__ bf16x8 tobf8(bf16x8 x) { return x; }
__device__ __forceinline__ int rel_bucket(int rel) {
    const int n = rel < 0 ? -rel : rel; int bk;
    if (n < 8) bk = n; else { int k = (31 - __builtin_clz((unsigned)(n * n))) - 6; bk = 8 + k; if (bk > 15) bk = 15; }
    return bk + (rel > 0 ? 16 : 0);
}

template <bool SMP>
__device__ __forceinline__ void attn_unit(Frame& F, int b, int h, int qb, float lam, float mshift) {
    using ST = typename std::conditional<SMP, f32x8, bf16x8>::type;
    const int tid = F.tid, lane = F.lane, w = F.wave, r32 = lane & 31, hi = lane >> 5;
    const int m = w >> 2, rb = SMP ? ((w >> 1) & 1) : (w & 3), kh = SMP ? (w & 1) : 0;
    const int NT = SMP ? 65 : 2 * qb + 2;
    const int qpos0 = SMP ? PAST : 128 * qb;
    const size_t qrow0 = SMP ? (size_t)MP + (size_t)b * DSEQ : (size_t)b * SEQ + 128 * qb;
    const int qpw = qpos0 + 32 * rb, cw = qpw >> 6;
    LAS unsigned char* L = F.lds;
    LAS float* TB = (LAS float*)(L + A_TB); LAS float* WSF = (LAS float*)(L + A_WS) + w * 64;
    const bf16* QB = (const bf16*)(F.ws + WS_Q); const bf16* KB = (const bf16*)(F.ws + WS_K); const bf16* VB = (const bf16*)(F.ws + WS_V); const bf16* ZB = (const bf16*)(F.ws + WS_ZB);
    bf16* YAB = (bf16*)(F.ws + WS_YAB);
    if (tid < 255) TB[tid] = F.in[17][rel_bucket(tid - 191) * NH + h] * LOG2E - mshift;
    bf16x8 qr[4];
    { const bf16* Qw = QB + (qrow0 + 32 * rb + r32) * DM + h * 128 + m * 64 + hi * 8;
#pragma unroll
      for (int d0 = 0; d0 < 4; ++d0) qr[d0] = *(const GAS bf16x8*)(Qw + d0 * 16); }
    const int sr = tid >> 4, sc = (tid & 15) * 8, vst0 = v_st(sr, sc), vst1 = v_st(32 + sr, sc);
    const int vb0 = (int)(uintptr_t)(L + A_V) + v_rd_base(lane) + kh * 8192;
    struct Slot { ST v0, v1, k0, k1; } sA, sB;
    const float* ck = F.in[2] + ((size_t)b * PAST * NH + h) * 128 + sc; const float* cv = F.in[3] + ((size_t)b * PAST * NH + h) * 128 + sc;
    const float* nk = F.out + O_KS + ((size_t)b * DSEQ * NH + h) * 128 + sc; const float* nv = F.out + O_VS + ((size_t)b * DSEQ * NH + h) * 128 + sc;
    const bf16* pk = KB + ((size_t)b * SEQ) * DM + h * 128 + sc; const bf16* pvp = VB + ((size_t)b * SEQ) * DM + h * 128 + sc;
#define SLOAD(s, j) do { if constexpr (SMP) { const float* kp_ = ((j) < 64) ? ck + (size_t)(j) * 64 * DM : nk; const float* vp_ = ((j) < 64) ? cv + (size_t)(j) * 64 * DM : nv; \
        s.v0 = __builtin_nontemporal_load((const f32x8*)(vp_ + (size_t)sr * DM)); s.v1 = __builtin_nontemporal_load((const f32x8*)(vp_ + (size_t)(32 + sr) * DM)); \
        s.k0 = __builtin_nontemporal_load((const f32x8*)(kp_ + (size_t)sr * DM)); s.k1 = __builtin_nontemporal_load((const f32x8*)(kp_ + (size_t)(32 + sr) * DM)); } \
      else { const bf16* kp_ = pk + (size_t)(j) * 64 * DM; const bf16* vp_ = pvp + (size_t)(j) * 64 * DM; \
        s.v0 = *(const GAS ST*)(vp_ + (size_t)sr * DM); s.v1 = *(const GAS ST*)(vp_ + (size_t)(32 + sr) * DM); s.k0 = *(const GAS ST*)(kp_ + (size_t)sr * DM); s.k1 = *(const GAS ST*)(kp_ + (size_t)(32 + sr) * DM); } } while (0)
#define SWRITE(bo, s) do { *(LAS bf16x8*)(L + A_V + (bo) + vst0) = tobf8(s.v0); *(LAS bf16x8*)(L + A_V + (bo) + vst1) = tobf8(s.v1); \
        *(LAS bf16x8*)(L + A_K + (bo) + KSWZ(sr, sc * 2)) = tobf8(s.k0); *(LAS bf16x8*)(L + A_K + (bo) + KSWZ(32 + sr, sc * 2)) = tobf8(s.k1); } while (0)
    f32x16 o[4]; float l_reg = 0.f;
#pragma unroll
    for (int d = 0; d < 4; ++d)
#pragma unroll
        for (int r = 0; r < 16; ++r) o[d][r] = 0.f;
#define ITER(j, s, bo) do { \
        if ((j) + 1 < NT) { if constexpr (SMP) asm volatile("s_waitcnt vmcnt(8)" ::: "memory"); else asm volatile("s_waitcnt vmcnt(4)" ::: "memory"); } else asm volatile("s_waitcnt vmcnt(0)" ::: "memory"); \
        SWRITE(bo, s); __syncthreads(); \
        if ((j) + 2 < NT) SLOAD(s, (j) + 2); \
        if ((j) <= cw) { \
            f32x16 p0, p1; \
            const int kofs = 64 * (j) + 32 * kh; \
            if ((j) >= cw - 2) { const int ib = kofs - (qpw + r32) + 191 + 4 * hi; \
                _Pragma("unroll") for (int r = 0; r < 16; ++r) { p0[r] = TB[ib + (r & 3) + 8 * (r >> 2)]; if constexpr (!SMP) p1[r] = TB[ib + 32 + (r & 3) + 8 * (r >> 2)]; } } \
            else { const float cf = TB[63]; _Pragma("unroll") for (int r = 0; r < 16; ++r) { p0[r] = cf; if constexpr (!SMP) p1[r] = cf; } } \
            const LAS unsigned char* Ks = L + A_K + (bo); \
            _Pragma("unroll") for (int d0 = 0; d0 < 4; ++d0) { const int cbb = (m * 64 + d0 * 16 + hi * 8) * 2; \
                const bf16x8 b0 = *(const LAS bf16x8*)(Ks + KSWZ(32 * kh + r32, cbb)); \
                p0 = __builtin_amdgcn_mfma_f32_32x32x16_bf16(b0, qr[d0], p0, 0, 0, 0); \
                if constexpr (!SMP) { const bf16x8 b1 = *(const LAS bf16x8*)(Ks + KSWZ(32 + r32, cbb)); p1 = __builtin_amdgcn_mfma_f32_32x32x16_bf16(b1, qr[d0], p1, 0, 0, 0); } } \
            float ps = 0.f; \
            _Pragma("unroll") for (int r = 0; r < 16; ++r) { p0[r] = __builtin_amdgcn_exp2f(p0[r]); ps += p0[r]; } \
            if constexpr (!SMP) { _Pragma("unroll") for (int r = 0; r < 16; ++r) { p1[r] = __builtin_amdgcn_exp2f(p1[r]); ps += p1[r]; } } \
            l_reg += ps; \
            bf16x8 pa0, pa1, pa2, pa3; \
            PK4(p0, 0, pa0); PK4(p0, 8, pa1); if constexpr (!SMP) { PK4(p1, 0, pa2); PK4(p1, 8, pa3); } else { pa2 = pa0; pa3 = pa1; } \
            SBAR(); \
            constexpr int NKS_ = SMP ? 2 : 4; \
            pv_one<0, NKS_>(o[0], vb0 + (bo), pa0, pa1, pa2, pa3); pv_one<1, NKS_>(o[1], vb0 + (bo), pa0, pa1, pa2, pa3); \
            pv_one<2, NKS_>(o[2], vb0 + (bo), pa0, pa1, pa2, pa3); pv_one<3, NKS_>(o[3], vb0 + (bo), pa0, pa1, pa2, pa3); \
        } } while (0)
#define PK4(P, BASE, OUT) do { unsigned a0 = pk2(P[BASE + 0], P[BASE + 1]), a1 = pk2(P[BASE + 2], P[BASE + 3]);   \
    unsigned b0_ = pk2(P[BASE + 4], P[BASE + 5]), b1_ = pk2(P[BASE + 6], P[BASE + 7]);                              \
    auto r0 = __builtin_amdgcn_permlane32_swap(a0, b0_, false, false); auto r1 = __builtin_amdgcn_permlane32_swap(a1, b1_, false, false); \
    v4u w_ = {r0[0], r1[0], r0[1], r1[1]}; OUT = __builtin_bit_cast(bf16x8, w_); } while (0)
    SLOAD(sA, 0); if (1 < NT) SLOAD(sB, 1);
    for (int j = 0; j < NT; j += 2) {
        ITER(j, sA, 0);
        if (j + 1 < NT) ITER(j + 1, sB, 16384);
    }
#undef ITER
#undef PK4
#undef SLOAD
#undef SWRITE
    __syncthreads();
    { auto rr = __builtin_amdgcn_permlane32_swap(__float_as_uint(l_reg), __float_as_uint(l_reg), false, false); l_reg = __uint_as_float(rr[0]) + __uint_as_float(rr[1]); }
    LAS float* X = (LAS float*)L;
    bool active = true;
    if constexpr (SMP) {
        const int wp = w >> 1;
        if (kh == 1) {
#pragma unroll
            for (int r = 0; r < 16; ++r)
#pragma unroll
                for (int d0 = 0; d0 < 4; ++d0) X[((wp * 16 + r) * 4 + d0) * 64 + lane] = o[d0][r];
            WSF[r32] = l_reg;
        }
        __syncthreads();
        if (kh == 0) {
#pragma unroll
            for (int r = 0; r < 16; ++r)
#pragma unroll
                for (int d0 = 0; d0 < 4; ++d0) o[d0][r] += X[((wp * 16 + r) * 4 + d0) * 64 + lane];
            l_reg += WSF[64 + r32];
        }
        __syncthreads();
        active = (kh == 0);
    }
    const int rbq = rb;
    float fr_[16];
    if (active) {
        const float f = (m == 0 ? 1.f : lam) / l_reg;
        if (hi == 0) WSF[r32] = f;
        LDS_WAIT();
#pragma unroll
        for (int r = 0; r < 16; ++r) fr_[r] = WSF[crow(r, hi)];
        if (m == 1) {
#pragma unroll
            for (int r = 0; r < 16; ++r)
#pragma unroll
                for (int d0 = 0; d0 < 4; ++d0) X[((rbq * 16 + r) * 4 + d0) * 64 + lane] = o[d0][r] * fr_[r];
        }
    }
    __syncthreads();
    if (active && m == 0) {
#pragma unroll
        for (int r = 0; r < 16; ++r)
#pragma unroll
            for (int d0 = 0; d0 < 4; ++d0) o[d0][r] = o[d0][r] * fr_[r] - X[((rbq * 16 + r) * 4 + d0) * 64 + lane];
    }
    __syncthreads();
    if (active && m == 0) {
#pragma unroll
        for (int r = 0; r < 16; ++r)
#pragma unroll
            for (int d0 = 0; d0 < 4; ++d0) X[(32 * rbq + crow(r, hi)) * 132 + 32 * d0 + r32] = o[d0][r];
    }
    __syncthreads();
    constexpr int R = SMP ? 64 : 128;
    if (tid < 4 * R) {
        const int row = tid >> 2, qd = tid & 3;
        float y[32]; float ss = 0.f;
#pragma unroll
        for (int i = 0; i < 8; ++i) { const f32x4 v = *(const LAS f32x4*)(X + row * 132 + 32 * qd + 4 * i); y[4 * i] = v.x; y[4 * i + 1] = v.y; y[4 * i + 2] = v.z; y[4 * i + 3] = v.w;
            ss += (v.x * v.x + v.y * v.y) + (v.z * v.z + v.w * v.w); }
        ss += __shfl_xor(ss, 1); ss += __shfl_xor(ss, 2);
        const float rinv = (1.f - LAM_INIT) / sqrtf(ss * (1.f / 128.f) + EPS);
        const size_t grow = qrow0 + row;
        const bf16* zp = ZB + grow * DM + h * 128 + 32 * qd; bf16* yp = YAB + grow * (2 * DM) + DM + h * 128 + 32 * qd; const float* gp = F.in[22] + 32 * qd;
#pragma unroll
        for (int i = 0; i < 4; ++i) { const v4u z = *(const GAS v4u*)(zp + 8 * i); const f32x4 g0 = *(const GAS f32x4*)(gp + 8 * i), g1 = *(const GAS f32x4*)(gp + 8 * i + 4);
            float v[8];
            v[0] = y[8 * i] * rinv * g0.x * bflo(z.x); v[1] = y[8 * i + 1] * rinv * g0.y * bfhi(z.x); v[2] = y[8 * i + 2] * rinv * g0.z * bflo(z.y); v[3] = y[8 * i + 3] * rinv * g0.w * bfhi(z.y);
            v[4] = y[8 * i + 4] * rinv * g1.x * bflo(z.z); v[5] = y[8 * i + 5] * rinv * g1.y * bfhi(z.z); v[6] = y[8 * i + 6] * rinv * g1.z * bflo(z.w); v[7] = y[8 * i + 7] * rinv * g1.w * bfhi(z.w);
            *(GAS v4u*)(yp + 8 * i) = pack8(v); }
    }
    __syncthreads();
}

struct Args { const float* in[26]; float* out; unsigned char* ws; int ph_lo, ph_hi, li, pad; };
__global__ void __launch_bounds__(NWAVES * 64, 2) skel_fwd(Args args) {
    extern __shared__ __attribute__((aligned(16))) unsigned char lds[];
    Frame F;
    F.lds = (LAS unsigned char*)lds;
    F.MISC = (volatile LAS unsigned*)(F.lds + MISC_OFF);
    F.tid = threadIdx.x; F.lane = F.tid & 63; F.wave = __builtin_amdgcn_readfirstlane(F.tid >> 6);
    F.G = gridDim.x; { const int bx = blockIdx.x; F.vcu = (F.G % 8 == 0) ? (bx % 8) * (F.G / 8) + bx / 8 : bx; }
    F.ws = args.ws; F.out = args.out; F.ctl = (gu32*)(args.ws + WS_CTL);
#pragma unroll
    for (int i = 0; i < 26; ++i) F.in[i] = args.in[i];
    for (int u = F.tid; u < (LDS_BYTES - LDSCTL_OFF) / 4; u += NWAVES * 64) ((LAS unsigned*)(F.lds + LDSCTL_OFF))[u] = 0u;
    __syncthreads();
    XcdBarrier bar; bar.bar = (unsigned*)(F.ctl + CW_BAR); bar.x = 0; bar.st = nullptr;
    if (N_LAUNCHES == 1) bar = xcd_barrier_post((unsigned*)(F.ctl + CW_BAR), F.MISC + 8);
#define GRID_BAR() do { if (N_LAUNCHES == 1) xcd_barrier(bar); } while (0)
    const int lo = args.ph_lo, hi = args.ph_hi;
#define IN(k) (lo <= (k) && (k) < hi)
#define BOTH(k) (IN(k) && IN((k) + 1))

    if (IN(0)) { p0_prologue(F); if (BOTH(0)) GRID_BAR(); }

    if (IN(1)) {
        pg8::Gemm g{(const bf16*)(F.ws + WS_XN), (const bf16*)(F.ws + WS_WIN), DM, DM, DM};
        pg8::StaticOrder S; S.init(MR, INC, F.G, (int)blockIdx.x);
        EpiIn E{F.ws, F.out, F.in[15], F.in[16]};
        pg8::gemm_phase<EpiIn, pg8::StaticOrder, true>(F.lds + RING_OFF, g, S, E);
        if (BOTH(1)) GRID_BAR();
    }

    if (IN(2)) {
        float lam, mshift;
        { const int l = F.lane;
          const float e1 = wave_sum(F.in[18][l] * F.in[19][l]), e2 = wave_sum(F.in[20][l] * F.in[21][l]);
          lam = expf(e1) - expf(e2) + LAM_INIT;
          const float gq = wave_max(fabsf(F.in[15][l])), gk = wave_max(fabsf(F.in[16][l]));
          float bm = fmaxf(fmaxf(F.in[17][l], F.in[17][64 + l]), fmaxf(F.in[17][128 + l], F.in[17][192 + l])); bm = wave_max(bm);
          mshift = fminf(8.f * gq * gk * LOG2E + fmaxf(bm, 0.f) * LOG2E, 60.f); }
        const int vcu = F.vcu;
        for (int i = vcu; i < 512; i += F.G) lru_unit(F, i >> 3, i & 7);
        {
            const bool bal = (F.G == 256);
            const int x = vcu >> 5, j = vcu & 31, s = j & 7, srnd = 4 * (vcu & 3);
            const int nU = bal ? 16 : (4096 + F.G - 1) / F.G;
            for (int u = 0; u < nU; ++u) {
                const int si = bal ? vcu : vcu + u * F.G;
                if (bal ? (u == srnd) : (si < 256)) attn_unit<true>(F, si >> 3, si & 7, 0, lam, mshift);
                int bh, qb;
                if (bal) { bh = 32 * x + 4 * (u >> 1) + (j >> 3); qb = (u & 1) ? s : 15 - s; }
                else { const int p = vcu + u * F.G; if (p >= 4096) break; bh = p >> 4; qb = p & 15; }
                attn_unit<false>(F, bh >> 3, bh & 7, qb, lam, mshift);
            }
        }
        if (BOTH(2)) GRID_BAR();
    }

    if (IN(3)) {
        pg8::Gemm g{(const bf16*)(F.ws + WS_YAB), (const bf16*)(F.ws + WS_WAB), 2 * DM, 2 * DM, DM};
        pg8::PairOrder S; S.b.init(MR, DM, F.G, (int)blockIdx.x);
        EpiProj E{(const bf16*)(F.ws + WS_GA), (const bf16*)(F.ws + WS_GB), (bf16*)(F.ws + WS_XN)};
        pg8::gemm_phase<EpiProj, pg8::PairOrder, false>(F.lds + RING_OFF, g, S, E);
        if (BOTH(3)) GRID_BAR();
    }

    if (IN(4)) {
        pg8::Gemm g{(const bf16*)(F.ws + WS_XN), (const bf16*)(F.ws + WS_WOUT), DM, DM, DM};
        pg8::StaticOrder S; S.init(MR, DM, F.G, (int)blockIdx.x);
        EpiOut E{F.in[0], F.in[1], F.out};
        pg8::gemm_phase<EpiOut, pg8::StaticOrder, false>(F.lds + RING_OFF, g, S, E);
    }
#undef IN
#undef BOTH
}

extern "C" void kernel_launch(void* const* d_in, const int* in_sizes, int n_in, void* d_out, int out_size, void* d_ws, size_t ws_size, hipStream_t stream) {
    static int grid = 0;
    if (grid == 0) {
        if (n_in != 26 || in_sizes[0] != MP * DM || (size_t)out_size != O_END || ws_size < WS_END) {
            fprintf(stderr, "kernel_launch: shape mismatch: n_in %d in0 %d out %d ws %zu (need %zu); nothing launched\n", n_in, n_in > 0 ? in_sizes[0] : -1, out_size, ws_size, (size_t)WS_END); grid = -1; return; }
        int dev = 0, cus = 0, per_cu = 0;
        if (hipGetDevice(&dev) != hipSuccess || hipDeviceGetAttribute(&cus, hipDeviceAttributeMultiprocessorCount, dev) != hipSuccess) { grid = -1; return; }
        if (hipFuncSetAttribute((const void*)skel_fwd, hipFuncAttributeMaxDynamicSharedMemorySize, LDS_BYTES) != hipSuccess) { fprintf(stderr, "kernel_launch: hipFuncSetAttribute failed\n"); grid = -1; return; }
        if (hipOccupancyMaxActiveBlocksPerMultiprocessor(&per_cu, (const void*)skel_fwd, NWAVES * 64, LDS_BYTES) != hipSuccess || per_cu < 1)
            fprintf(stderr, "kernel_launch: note: occupancy query reports %d workgroups per CU\n", per_cu);
        (void)hipGetLastError();
        grid = cus;
    }
    if (grid < 0) return;
    if (hipMemsetAsync((char*)d_ws + WS_CTL, 0, CTL_ZERO_BYTES, stream) != hipSuccess) return;
    Args a{};
    for (int i = 0; i < 26; ++i) a.in[i] = (const float*)d_in[i];
    a.out = (float*)d_out; a.ws = (unsigned char*)d_ws;
    for (int li = 0; li < N_LAUNCHES; ++li) {
        a.ph_lo = (N_LAUNCHES == 1) ? 0 : li; a.ph_hi = (N_LAUNCHES == 1) ? PER_PHASE : li + 1; a.li = li; a.pad = 0;
        hipLaunchKernelGGL(skel_fwd, dim3(grid), dim3(NWAVES * 64), LDS_BYTES, stream, a);
        const hipError_t le = hipPeekAtLastError();
        if (le != hipSuccess) { fprintf(stderr, "kernel_launch: launch %d failed: %s\n", li, hipGetErrorName(le)); break; }
    }
}
```

```cpp
#include <hip/hip_runtime.h>
#include <cstdio>
#include <cstdint>
#include <type_traits>

#ifndef MK_N_LAUNCHES
#define MK_N_LAUNCHES 1
#endif
#ifndef PROBE_DUP
#define PROBE_DUP 0
#endif
#ifndef PROBE_TS
#define PROBE_TS 0
#endif
#ifndef PROBE_MULT
#define PROBE_MULT 10
#endif
#define PTS_BEGIN(id, cond) do { if (PROBE_TS == (id) && blockIdx.x == 0 && (cond)) F.pt0 = __builtin_amdgcn_s_memrealtime(); } while (0)
#define PTS_END(id, cond) do { if (PROBE_TS == (id) && blockIdx.x == 0 && (cond)) F.pacc += __builtin_amdgcn_s_memrealtime() - F.pt0; } while (0)

namespace pg8 {
#define PG8_LAS __attribute__((address_space(3)))
typedef unsigned short bf16_t;
typedef short bf16x8 __attribute__((ext_vector_type(8)));
typedef float f32x4 __attribute__((ext_vector_type(4)));
typedef unsigned u32x4 __attribute__((ext_vector_type(4)));
constexpr int BM = 256, BK = 64, HALF = 128, HTB = HALF * BK * 2, STAGE_BYTES = 8 * HTB, NXCD = 8, WGM = 8;

__host__ __device__ __forceinline__ int lds_byte(int r, int c) { const int st = (r >> 4) * 2 + (c >> 5), rr = r & 15, cc = c & 31, ob = rr * 64 + cc * 2; return st * 1024 + (ob ^ (((ob >> 9) & 1) << 5)); }
__host__ __device__ __forceinline__ void stage_rc(int b, int& R, int& C) { const int st = b / 1024, sb = b % 1024, swz = sb ^ (((sb >> 9) & 1) << 5); R = (st >> 1) * 16 + swz / 64; C = (st & 1) * 32 + (swz % 64) / 2; }
__host__ __device__ __forceinline__ int perm32(int rho) { const int n = rho >> 4, i = rho & 15; return 8 * (i >> 2) + 4 * n + (i & 3); }

struct Unit { int pm, pn, kp; };
struct Gemm { const bf16_t* A; const bf16_t* Bt; int lda, ldb, K; };

struct StaticOrder {
    int nM, nN, nwg, G, c;
    __host__ __device__ void init(int M, int N, int G_, int c_) { nM = M / BM; nN = N / BM; nwg = nM * nN; G = G_; c = c_; }
    __host__ __device__ bool map(long L, Unit& u) const {
        if (L >= nwg) return false;
        int wgid = (int)L; { const int q = nwg / NXCD, r = nwg % NXCD, xcd = wgid % NXCD, off = wgid / NXCD; wgid = (xcd < r ? xcd * (q + 1) : r * (q + 1) + (xcd - r) * q) + off; }
        const int nig = WGM * nN, gid = wgid / nig, fm = gid * WGM, gsz = (nM - fm) < WGM ? (nM - fm) : WGM;
        u.pm = fm + ((wgid % nig) % gsz); u.pn = (wgid % nig) / gsz; u.kp = 0; return true;
    }
    __host__ __device__ bool next(int i, Unit& u) const { if (PROBE_DUP == 1 && nN == 32) { if (i >= 66) return false; if (i >= 33) i -= 33; } return map((long)i * G + c, u); }
};
struct XcdRowOrder {
    StaticOrder b;
    __host__ __device__ bool next(int i, Unit& u) const {
        if (b.G != 256 || b.nM != 264 || b.nN != 32) return b.next(i, u);
        if (i > 32) return false;
        const int x = b.c & 7, k = b.c >> 3;
        if (i < 32) { const int g = i >> 3, ci = (i + x) & 7; u.pm = 33 * x + 8 * g + (k & 7); u.pn = 4 * ci + (k >> 3); }
        else { u.pm = 33 * (k & 7) + 32; u.pn = 8 * (k >> 3) + x; }
        u.kp = 0; return true;
    }
};
struct PairOrder {
    StaticOrder b;
    __host__ __device__ bool next(int i, Unit& u) const { if (!b.map((long)(i >> 1) * b.G + b.c, u)) return false; u.kp = i & 1; return true; }
};

__device__ __forceinline__ unsigned cvt_pk_bf16(float lo, float hi) { unsigned r; asm volatile("v_cvt_pk_bf16_f32 %0, %1, %2" : "=v"(r) : "v"(lo), "v"(hi)); return r; }

template <class Epi, class Sched, bool ALIGN_EPI>
__device__ __forceinline__ unsigned long long gemm_phase(PG8_LAS unsigned char* lds, const Gemm g, const Sched& S, const Epi& E, const int probe_id) {
    unsigned long long pacc = 0, pt0 = 0, pt1 = 0;
    const int tid = threadIdx.x, wid = __builtin_amdgcn_readfirstlane(tid >> 6), lane = tid & 63, wr = wid >> 2, wc = wid & 3, fr = lane & 15, fq = lane >> 4;
    const int K = g.K, nt = K / BK;
    unsigned voffA[2], voffB[2];
#pragma unroll
    for (int i = 0; i < 2; ++i) { int R, C; stage_rc(tid * 16 + i * 8192, R, C); const int Rb = Epi::PERM ? ((R & ~31) + perm32(R & 31)) : R;
        voffA[i] = (unsigned)(R * g.lda + C) * 2u; voffB[i] = (unsigned)(Rb * g.ldb + C) * 2u; }
    const size_t kstep = (size_t)(BK * 2);
    const size_t hstepA = (size_t)HALF * g.lda * 2, hstepB = (size_t)HALF * g.ldb * 2;
    const size_t tstepA = 2 * hstepA, tstepB = 2 * hstepB;
    const unsigned ldsw = (unsigned)wid * 1024u;
    const int aoff = lds_byte(wr * 64 + fr, fq * 8), boff = lds_byte(wc * 32 + fr, fq * 8);
#define PG8_SA(b, h) (((b) * 2 + (h)) * HTB)
#define PG8_SB(b, h) ((4 + (b) * 2 + (h)) * HTB)
#define PG8_STAGE(bufoff, gbase, voff) do { _Pragma("unroll") for (int _i = 0; _i < 2; ++_i) \
        __builtin_amdgcn_global_load_lds((const unsigned*)((const char*)(gbase) + (voff)[_i]), (PG8_LAS unsigned*)(lds + (bufoff) + ldsw + _i * 8192), 16, 0, 0); } while (0)
#define PG8_LDA(dst, b, h) do { _Pragma("unroll") for (int m = 0; m < 4; ++m) _Pragma("unroll") for (int k = 0; k < 2; ++k) dst[m][k] = *(const PG8_LAS bf16x8*)(lds + PG8_SA(b, h) + aoff + m * 2048 + k * 1024); } while (0)
#define PG8_LDB(dst, b, h) do { _Pragma("unroll") for (int n = 0; n < 2; ++n) _Pragma("unroll") for (int k = 0; k < 2; ++k) dst[n][k] = *(const PG8_LAS bf16x8*)(lds + PG8_SB(b, h) + boff + n * 2048 + k * 1024); } while (0)
#define PG8_MMA(ai, bj, At, Bt) do { __builtin_amdgcn_s_setprio(1); _Pragma("unroll") for (int m = 0; m < 4; ++m) _Pragma("unroll") for (int n = 0; n < 2; ++n) _Pragma("unroll") for (int k = 0; k < 2; ++k) \
        acc[ai][bj][m][n] = __builtin_amdgcn_mfma_f32_16x16x32_bf16(Bt[n][k], At[m][k], acc[ai][bj][m][n], 0, 0, 0); __builtin_amdgcn_s_setprio(0); } while (0)
#define PG8_WAIT_V(n) asm volatile("s_waitcnt vmcnt(" #n ")" ::: "memory")
#define PG8_WAIT_L(n) asm volatile("s_waitcnt lgkmcnt(" #n ")" ::: "memory")
#define PG8_BAR __builtin_amdgcn_s_barrier()
#define PG8_SCHED __builtin_amdgcn_sched_barrier(0)
    Unit cur, nxt; int ui = 0;
    if (!S.next(0, cur)) return 0;
    f32x4 acc[2][2][4][2];
#pragma unroll
    for (int a = 0; a < 2; ++a)
#pragma unroll
        for (int b = 0; b < 2; ++b)
#pragma unroll
            for (int m = 0; m < 4; ++m)
#pragma unroll
                for (int n = 0; n < 2; ++n) acc[a][b][m][n] = (f32x4){0.f, 0.f, 0.f, 0.f};
    bf16x8 At[4][2], B0[2][2], B1[2][2];
    const char* cA = (const char*)g.A + (size_t)cur.pm * tstepA + (size_t)cur.kp * K * 2; const char* cB = (const char*)g.Bt + (size_t)cur.pn * tstepB + (size_t)cur.kp * K * 2;
    PG8_STAGE(PG8_SB(0, 0), cB, voffB); PG8_STAGE(PG8_SB(0, 1), cB + hstepB, voffB); PG8_STAGE(PG8_SA(0, 0), cA, voffA); PG8_STAGE(PG8_SA(0, 1), cA + hstepA, voffA);
    if (wr == 1) PG8_BAR;
    PG8_WAIT_V(2); PG8_BAR;
    PG8_STAGE(PG8_SB(1, 0), cB + kstep, voffB); PG8_STAGE(PG8_SA(1, 0), cA + kstep, voffA); PG8_STAGE(PG8_SB(1, 1), cB + hstepB + kstep, voffB);
    PG8_WAIT_V(6); PG8_BAR;
    for (;;) {
        const bool has_next = S.next(ui + 1, nxt);
        if ((PROBE_TS == 4 || PROBE_TS == 6) && probe_id == 1 && blockIdx.x == 0) pt0 = __builtin_amdgcn_s_memrealtime();
        const char* nA = has_next ? (const char*)g.A + (size_t)nxt.pm * tstepA + (size_t)nxt.kp * K * 2 : cA; const char* nB = has_next ? (const char*)g.Bt + (size_t)nxt.pn * tstepB + (size_t)nxt.kp * K * 2 : cB;
        for (int t = 0; t < nt; t += 2) {
            const bool last = (t == nt - 2);
            const char* a1 = cA + (size_t)(t + 1) * kstep;
            const char* a2 = last ? nA : cA + (size_t)(t + 2) * kstep; const char* b2 = last ? nB : cB + (size_t)(t + 2) * kstep;
            const char* a3 = a2 + kstep; const char* b3 = b2 + kstep;
            PG8_LDB(B0, 0, 0); PG8_LDB(B1, 0, 1); PG8_SCHED; PG8_LDA(At, 0, 0); PG8_STAGE(PG8_SA(1, 1), a1 + hstepA, voffA);
            PG8_WAIT_V(8); PG8_WAIT_L(0); PG8_BAR; PG8_MMA(0, 0, At, B0); PG8_MMA(0, 1, At, B1); PG8_BAR; PG8_SCHED;
            PG8_LDA(At, 0, 1); PG8_STAGE(PG8_SB(0, 0), b2, voffB); PG8_STAGE(PG8_SB(0, 1), b2 + hstepB, voffB); PG8_STAGE(PG8_SA(0, 0), a2, voffA);
            PG8_WAIT_V(8); PG8_WAIT_L(0); PG8_BAR; PG8_MMA(1, 0, At, B0); PG8_MMA(1, 1, At, B1); PG8_BAR; PG8_SCHED;
            PG8_LDB(B0, 1, 0); PG8_LDB(B1, 1, 1); PG8_SCHED; PG8_LDA(At, 1, 0); PG8_STAGE(PG8_SA(0, 1), a2 + hstepA, voffA);
            PG8_WAIT_V(8); PG8_WAIT_L(0); PG8_BAR; PG8_MMA(0, 0, At, B0); PG8_MMA(0, 1, At, B1); PG8_BAR; PG8_SCHED;
            PG8_LDA(At, 1, 1); PG8_STAGE(PG8_SB(1, 0), b3, voffB); PG8_STAGE(PG8_SB(1, 1), b3 + hstepB, voffB); PG8_STAGE(PG8_SA(1, 0), a3, voffA);
            PG8_WAIT_V(8); PG8_WAIT_L(0); PG8_BAR; PG8_MMA(1, 0, At, B0); PG8_MMA(1, 1, At, B1); PG8_BAR; PG8_SCHED;
        }
        if constexpr (ALIGN_EPI) { if (wr == 0) PG8_BAR; }
        if (PROBE_TS == 4 && probe_id == 1 && blockIdx.x == 0) pacc += __builtin_amdgcn_s_memrealtime() - pt0;
        if (PROBE_TS == 5 && probe_id == 1 && blockIdx.x == 0) pt1 = __builtin_amdgcn_s_memrealtime();
        const bool keep = E(acc, cur, wr, wc, fr, fq);
        if (PROBE_TS == 5 && probe_id == 1 && blockIdx.x == 0) pacc += __builtin_amdgcn_s_memrealtime() - pt1;
        if (PROBE_TS == 6 && probe_id == 1 && blockIdx.x == 0 && (cur.pn >> 2) == 4) pacc += __builtin_amdgcn_s_memrealtime() - pt0;
        if (!has_next) break;
        if (!keep) {
#pragma unroll
        for (int a = 0; a < 2; ++a)
#pragma unroll
            for (int b = 0; b < 2; ++b)
#pragma unroll
                for (int m = 0; m < 4; ++m)
#pragma unroll
                    for (int n = 0; n < 2; ++n) acc[a][b][m][n] = (f32x4){0.f, 0.f, 0.f, 0.f};
        }
        cur = nxt; cA = nA; cB = nB; ++ui;
        if constexpr (ALIGN_EPI) { if (wr == 1) PG8_BAR; }
    }
    PG8_WAIT_V(0);
    if constexpr (!ALIGN_EPI) { if (wr == 0) PG8_BAR; }
    PG8_BAR;
    return pacc;
#undef PG8_SA
#undef PG8_SB
#undef PG8_STAGE
#undef PG8_LDA
#undef PG8_LDB
#undef PG8_MMA
#undef PG8_WAIT_V
#undef PG8_WAIT_L
#undef PG8_BAR
#undef PG8_SCHED
}
}

constexpr int NWAVES = 8;
constexpr int N_LAUNCHES = MK_N_LAUNCHES;
constexpr int PER_PHASE = 5;
constexpr int DM = 1024, SEQ = 2048, NB = 32, DSEQ = 64, PAST = 4096, NH = 8, INC = 8192;
constexpr int MP = NB * SEQ;
constexpr int MS = NB * DSEQ;
constexpr int MR = MP + MS;
constexpr float EPS = 1e-6f, LOG2E = 1.4426950408889634f;
constexpr float QSCALE = 0.125f * LOG2E;
constexpr float LAM_INIT = 0.2f;
constexpr size_t O_YP = 0, O_YS = 67108864, O_KP = 69206016, O_VP = 136314880, O_CP = 203423744, O_LP = 203522048,
                 O_KS = 203554816, O_VS = 205651968, O_CS = 207749120, O_LS = 207847424, O_END = 207880192;
constexpr size_t MiB = 1u << 20;
constexpr size_t ACT = (size_t)MR * DM * 2;
constexpr size_t WS_CTL = 0, CTL_ZERO_BYTES = 1 * MiB;
constexpr size_t WS_WIN = 2 * MiB, WS_WAB = 18 * MiB, WS_WOUT = 22 * MiB, WS_WG = 24 * MiB;
constexpr size_t WS_XN = 32 * MiB;
constexpr size_t WS_XA = WS_XN + ACT, WS_ZA = WS_XA + ACT, WS_Q = WS_ZA + ACT, WS_K = WS_Q + ACT, WS_V = WS_K + ACT, WS_ZB = WS_V + ACT, WS_GA = WS_ZB + ACT, WS_GB = WS_GA + ACT;
constexpr size_t WS_YAB = WS_GB + ACT;
constexpr size_t WS_END = WS_YAB + 2 * ACT;
constexpr int CW_TMO = 0, CW_BAR = 4096, CW_GRP = 8192;

constexpr int RING_OFF = 0, RING_BYTES = 131072;
constexpr int LDSCTL_OFF = RING_BYTES, MISC_OFF = LDSCTL_OFF + 320;
constexpr int LDS_BYTES = 147456;

#define GAS __attribute__((address_space(1)))
#define LAS __attribute__((address_space(3)))
typedef unsigned short bf16;
typedef unsigned v4u __attribute__((ext_vector_type(4)));
typedef float f32x4 __attribute__((ext_vector_type(4)));
typedef float f32x8 __attribute__((ext_vector_type(8)));
typedef float f32x16 __attribute__((ext_vector_type(16)));
typedef short bf16x8 __attribute__((ext_vector_type(8)));
typedef short s16x4 __attribute__((ext_vector_type(4)));
typedef GAS unsigned gu32;
#define RLX_AGENT __ATOMIC_RELAXED, __HIP_MEMORY_SCOPE_AGENT
#define LDS_WAIT() asm volatile("s_waitcnt lgkmcnt(0)" ::: "memory")
#define VM_WAIT() asm volatile("s_waitcnt vmcnt(0)" ::: "memory")
__device__ __forceinline__ unsigned pk2(float lo, float hi) { return pg8::cvt_pk_bf16(lo, hi); }
__device__ __forceinline__ float bf2f(unsigned short v) { return __builtin_bit_cast(float, (unsigned)v << 16); }
__device__ __forceinline__ float bflo(unsigned w) { return __builtin_bit_cast(float, w << 16); }
__device__ __forceinline__ float bfhi(unsigned w) { return __builtin_bit_cast(float, w & 0xffff0000u); }
__device__ __forceinline__ float sigm(float v) { return __builtin_amdgcn_rcpf(1.f + __builtin_amdgcn_exp2f(-LOG2E * v)); }

#define XB_TMO      128
#define XB_XCNT(j)  (256  + 64 * (j))
#define XB_XSUB(j)  (1280 + 64 * (j))
#define XB_XGEN(j)  (2304 + 64 * (j))
#define XB_TOP      3328
#define XB_TOPGEN   3392
#define XCD_BAR_WORDS 3456
#define XB_SPIN_CAP (1u << 18)
__device__ __forceinline__ unsigned xb_ld(unsigned* p)              { return __hip_atomic_load(p, __ATOMIC_RELAXED, __HIP_MEMORY_SCOPE_AGENT); }
__device__ __forceinline__ unsigned xb_add(unsigned* p, unsigned v) { return __hip_atomic_fetch_add(p, v, __ATOMIC_RELAXED, __HIP_MEMORY_SCOPE_AGENT); }
__device__ __forceinline__ unsigned xb_xcc_id() { return (unsigned)__builtin_amdgcn_s_getreg((3 << 11) | 20) & 0xFu; }
#define XB_SPIN(cond, bar) do { unsigned _sp = 0; while (cond) { __builtin_amdgcn_s_sleep(1); \
    if ((++_sp & 255u) == 0u) { if (xb_ld(&(bar)[XB_TMO])) break; if (_sp > XB_SPIN_CAP) { atomicAdd(&(bar)[XB_TMO], 1u); break; } } } } while (0)
struct XcdBarrier { unsigned* bar; unsigned x; volatile LAS unsigned* st; };
__device__ __forceinline__ XcdBarrier xcd_barrier_post(unsigned* bar, volatile LAS unsigned* st) {
    XcdBarrier b; b.bar = bar; b.x = xb_xcc_id(); b.st = st;
    if (threadIdx.x == 0) (void)xb_add(&bar[XB_XCNT(b.x)], 1u);
    return b;
}
__device__ __forceinline__ void xcd_barrier_complete(unsigned* bar, unsigned x, unsigned& nloc, unsigned& nx) {
    const unsigned G = gridDim.x * gridDim.y * gridDim.z;
    unsigned sum, cnt, mine, sp = 0u;
    for (;;) {
        sum = 0u; cnt = 0u; mine = 0u;
#pragma unroll
        for (unsigned j = 0; j < 16; ++j) { const unsigned c = xb_ld(&bar[XB_XCNT(j)]); sum += c; cnt += (c > 0u) ? 1u : 0u; mine = (j == x) ? c : mine; }
        if (sum == G) break;
        __builtin_amdgcn_s_sleep(1);
        if ((++sp & 255u) == 0u) { if (xb_ld(&bar[XB_TMO])) break; if (sp > XB_SPIN_CAP) { atomicAdd(&bar[XB_TMO], 1u); break; } }
    }
    nloc = mine > 0u ? mine : 1u; nx = cnt > 0u ? cnt : 1u;
}
__device__ __forceinline__ void xcd_barrier(const XcdBarrier& b) {
    asm volatile("s_waitcnt vmcnt(0)" ::: "memory");
    __syncthreads();
    if (threadIdx.x == 0) {
        unsigned* bar = b.bar;
        __builtin_amdgcn_s_waitcnt(0);
        unsigned nloc = b.st[0], nx = b.st[1];
        if (nloc == 0u) { xcd_barrier_complete(bar, b.x, nloc, nx); b.st[0] = nloc; b.st[1] = nx; }
        const unsigned old = xb_add(&bar[XB_XSUB(b.x)], 1u);
        const unsigned gen = old / nloc;
        if (old + 1u == (gen + 1u) * nloc) {
            __builtin_amdgcn_fence(__ATOMIC_RELEASE, "agent");
            asm volatile("s_waitcnt vmcnt(0)" ::: "memory");
            const unsigned og = xb_add(&bar[XB_TOP], 1u);
            const unsigned tg = og / nx;
            if (og + 1u == (tg + 1u) * nx) xb_add(&bar[XB_TOPGEN], 1u);
            else XB_SPIN(xb_ld(&bar[XB_TOPGEN]) == tg, bar);
            __builtin_amdgcn_fence(__ATOMIC_ACQUIRE, "agent");
            xb_add(&bar[XB_XGEN(b.x)], 1u);
            asm volatile("s_waitcnt vmcnt(0)" ::: "memory");
        } else {
            XB_SPIN(xb_ld(&bar[XB_XGEN(b.x)]) == gen, bar);
            __builtin_amdgcn_fence(__ATOMIC_ACQUIRE, "agent");
            asm volatile("s_waitcnt vmcnt(0)" ::: "memory");
        }
    }
    __syncthreads();
}

__device__ __forceinline__ void group_barrier(unsigned* bar, unsigned* cnt, const unsigned n, const bool t0) {
    asm volatile("s_waitcnt vmcnt(0)" ::: "memory");
    __syncthreads();
    if (t0) {
        __builtin_amdgcn_fence(__ATOMIC_RELEASE, "agent");
        asm volatile("s_waitcnt vmcnt(0)" ::: "memory");
        (void)xb_add(cnt, 1u);
        XB_SPIN(xb_ld(cnt) < n, bar);
        __builtin_amdgcn_fence(__ATOMIC_ACQUIRE, "agent");
        asm volatile("s_waitcnt vmcnt(0)" ::: "memory");
    }
    __syncthreads();
}

struct Frame {
    LAS unsigned char* lds;
    volatile LAS unsigned* MISC;
    gu32* ctl;
    int tid, lane, wave;
    int vcu, G;
    const float* in[26]; float* out; unsigned char* ws;
    unsigned long long pt0, pacc;
};
__device__ __forceinline__ float wave_sum(float v) {
#pragma unroll
    for (int o = 1; o < 64; o <<= 1) v += __shfl_xor(v, o);
    return v;
}
__device__ __forceinline__ float wave_max(float v) {
#pragma unroll
    for (int o = 1; o < 64; o <<= 1) v = fmaxf(v, __shfl_xor(v, o));
    return v;
}

__device__ __forceinline__ void p0_transpose_item(const float* W, int ldw, int k0, int n0, bf16* WT, int ldt, int trow0, int tcol0, LAS float* scr, int lane) {
#pragma unroll 8
    for (int i = 0; i < 32; ++i) { const int kk = 2 * i + (lane >> 5); scr[kk * 33 + (lane & 31)] = W[(size_t)(k0 + kk) * ldw + n0 + (lane & 31)]; }
    LDS_WAIT(); asm volatile("" ::: "memory");
    const int c = lane & 7;
#pragma unroll
    for (int j = 0; j < 4; ++j) { const int n = (lane >> 3) + 8 * j; const LAS float* s = scr + (8 * c) * 33 + n;
        v4u o; o.x = pk2(s[0 * 33], s[1 * 33]); o.y = pk2(s[2 * 33], s[3 * 33]); o.z = pk2(s[4 * 33], s[5 * 33]); o.w = pk2(s[6 * 33], s[7 * 33]);
        *(GAS v4u*)(WT + (size_t)(trow0 + n) * ldt + tcol0 + 8 * c) = o; }
    LDS_WAIT(); asm volatile("" ::: "memory");
}
__device__ __forceinline__ void rms_row_to_bf16(const float* xrow, const float* gain, bf16* orow, int lane) {
    const GAS f32x4* xr = (const GAS f32x4*)xrow + lane; const GAS f32x4* gr = (const GAS f32x4*)gain + lane;
    f32x4 v[4]; float s = 0.f;
#pragma unroll
    for (int j = 0; j < 4; ++j) { v[j] = xr[64 * j]; s += (v[j].x * v[j].x + v[j].y * v[j].y) + (v[j].z * v[j].z + v[j].w * v[j].w); }
    const float rinv = 1.f / sqrtf(wave_sum(s) * (1.f / DM) + EPS);
    GAS unsigned long long* o8 = (GAS unsigned long long*)orow + lane;
#pragma unroll
    for (int j = 0; j < 4; ++j) { const f32x4 g = gr[64 * j];
        o8[64 * j] = (unsigned long long)pk2(v[j].x * rinv * g.x, v[j].y * rinv * g.y) | ((unsigned long long)pk2(v[j].z * rinv * g.z, v[j].w * rinv * g.w) << 32); }
}
__device__ __forceinline__ void p0_prologue(Frame& F) {
    LAS float* scr = (LAS float*)(F.lds + RING_OFF + F.wave * 16384);
    const int gw = F.vcu * NWAVES + F.wave, NGW = F.G * NWAVES;
    bf16* WIN = (bf16*)(F.ws + WS_WIN); bf16* WAB = (bf16*)(F.ws + WS_WAB); bf16* WOUT = (bf16*)(F.ws + WS_WOUT); bf16* WG = (bf16*)(F.ws + WS_WG);
    constexpr int I_IN = 16 * 256, I_P = 16 * 32, I_G = 16 * 2 * 4;
    constexpr int NITEMS = I_IN + 3 * I_P + I_G;
    for (int it = gw; it < NITEMS; it += NGW) {
        int r = it;
        if (r < I_IN) { const int kb = r / 256, nb = r % 256, n0 = nb * 32; const int within = n0 & 255, wc = within >> 6, bj = (within >> 5) & 1;
            int trow = (n0 & ~255) + bj * 128 + wc * 32;
            if (n0 >= 6144) { const int gs = n0 >= 7168, oc0 = n0 - 6144 - 1024 * gs; trow = (24 + (oc0 >> 7)) * 256 + gs * 128 + ((oc0 >> 5) & 3) * 32; }
            p0_transpose_item(F.in[7], INC, kb * 64, n0, WIN, DM, trow, kb * 64, scr, F.lane); continue; } r -= I_IN;
        if (r < I_P) { const int kb = r / 32, nb = r % 32; p0_transpose_item(F.in[23], DM, kb * 64, nb * 32, WAB, 2 * DM, nb * 32, kb * 64, scr, F.lane); continue; } r -= I_P;
        if (r < I_P) { const int kb = r / 32, nb = r % 32; p0_transpose_item(F.in[24], DM, kb * 64, nb * 32, WAB, 2 * DM, nb * 32, DM + kb * 64, scr, F.lane); continue; } r -= I_P;
        if (r < I_P) { const int kb = r / 32, nb = r % 32; p0_transpose_item(F.in[25], DM, kb * 64, nb * 32, WOUT, DM, nb * 32, kb * 64, scr, F.lane); continue; } r -= I_P;
        { const int blk = r / 8, sub = r % 8, kb = sub / 4, nb = sub % 4, n = blk >> 1, g = blk & 1;
          p0_transpose_item((g ? F.in[12] : F.in[10]) + (size_t)n * 16384, 128, kb * 64, nb * 32, WG + (size_t)blk * 16384, 128, nb * 32, kb * 64, scr, F.lane); }
    }
    bf16* XN = (bf16*)(F.ws + WS_XN);
    f32x4 gv[4];
#pragma unroll
    for (int j = 0; j < 4; ++j) gv[j] = *((const GAS f32x4*)F.in[6] + F.lane + 64 * j);
    for (int m0 = gw * 4; m0 < MR; m0 += NGW * 4) {
        const float* xr = (m0 < MP) ? F.in[0] + (size_t)m0 * DM : F.in[1] + (size_t)(m0 - MP) * DM;
        f32x4 v[4][4];
#pragma unroll
        for (int r = 0; r < 4; ++r)
#pragma unroll
            for (int j = 0; j < 4; ++j) v[r][j] = *((const GAS f32x4*)(xr + (size_t)r * DM) + F.lane + 64 * j);
        __builtin_amdgcn_sched_barrier(0);
#pragma unroll
        for (int r = 0; r < 4; ++r) {
            float ssq = 0.f;
#pragma unroll
            for (int j = 0; j < 4; ++j) ssq += (v[r][j].x * v[r][j].x + v[r][j].y * v[r][j].y) + (v[r][j].z * v[r][j].z + v[r][j].w * v[r][j].w);
            const float rinv = 1.f / sqrtf(wave_sum(ssq) * (1.f / DM) + EPS);
            GAS unsigned long long* o8 = (GAS unsigned long long*)(XN + (size_t)(m0 + r) * DM) + F.lane;
#pragma unroll
            for (int j = 0; j < 4; ++j) o8[64 * j] = (unsigned long long)pk2(v[r][j].x * rinv * gv[j].x, v[r][j].y * rinv * gv[j].y) | ((unsigned long long)pk2(v[r][j].z * rinv * gv[j].z, v[r][j].w * rinv * gv[j].w) << 32);
        }
    }
}

__device__ __forceinline__ v4u pack8(const float* v) { v4u w; w.x = pk2(v[0], v[1]); w.y = pk2(v[2], v[3]); w.z = pk2(v[4], v[5]); w.w = pk2(v[6], v[7]); return w; }
struct EpiIn {
    static constexpr bool PERM = true;
    unsigned char* ws; float* out; const float* qg; const float* kg;
    __device__ __forceinline__ bool operator()(pg8::f32x4 (&acc)[2][2][4][2], const pg8::Unit& u, int wr, int wc, int fr, int fq) const {
        const int g = u.pn >> 2;
        const int cb = (u.pn & 3) * 256 + wc * 64 + fq * 8;
        const int row0 = u.pm * 256 + wr * 64 + fr;
        const bool smp = u.pm >= 256;
        if (g == 2 || g == 3) {
            const float* gn = (g == 2) ? qg : kg; const float sc = (g == 2) ? QSCALE : 1.f;
            float gv[2][8];
#pragma unroll
            for (int bj = 0; bj < 2; ++bj)
#pragma unroll
                for (int e = 0; e < 8; ++e) gv[bj][e] = gn[bj * 32 + fq * 8 + e] * sc;
            bf16* dstb = (bf16*)(ws + (g == 2 ? WS_Q : WS_K));
            float* kout = smp ? out + O_KS - (size_t)MP * DM : out + O_KP;
#pragma unroll
            for (int ai = 0; ai < 2; ++ai)
#pragma unroll
                for (int m = 0; m < 4; ++m) {
                    const size_t row = (size_t)(row0 + ai * 128 + m * 16);
                    float ss = 0.f;
#pragma unroll
                    for (int bj = 0; bj < 2; ++bj)
#pragma unroll
                        for (int n = 0; n < 2; ++n) { const pg8::f32x4 a = acc[ai][bj][m][n]; ss += (a.x * a.x + a.y * a.y) + (a.z * a.z + a.w * a.w); }
                    ss += __shfl_xor(ss, 16); ss += __shfl_xor(ss, 32);
                    const float rinv = 1.f / sqrtf(ss * (1.f / 64.f) + EPS);
#pragma unroll
                    for (int bj = 0; bj < 2; ++bj) {
                        float v[8];
#pragma unroll
                        for (int e = 0; e < 8; ++e) v[e] = acc[ai][bj][m][e >> 2][e & 3] * rinv * gv[bj][e];
                        *(GAS v4u*)(dstb + row * DM + cb + bj * 32) = pack8(v);
                        if (g == 3) { GAS f32x4* o = (GAS f32x4*)(kout + row * DM + cb + bj * 32); o[0] = (f32x4){v[0], v[1], v[2], v[3]}; o[1] = (f32x4){v[4], v[5], v[6], v[7]}; }
                    }
                }
            return false;
        }
        if (g >= 6) {
            bf16* Rb = (bf16*)(ws + WS_GA); bf16* Gb = (bf16*)(ws + WS_GB);
            const int oc = (u.pn - 24) * 128 + wc * 32 + fq * 8;
#pragma unroll
            for (int ai = 0; ai < 2; ++ai)
#pragma unroll
                for (int m = 0; m < 4; ++m) {
                    const size_t row = (size_t)(row0 + ai * 128 + m * 16);
                    float rr[8], gg[8];
#pragma unroll
                    for (int e = 0; e < 8; ++e) { const float ea = __builtin_amdgcn_exp2f(-LOG2E * acc[ai][0][m][e >> 2][e & 3]), eb = __builtin_amdgcn_exp2f(-LOG2E * acc[ai][1][m][e >> 2][e & 3]);
                        gg[e] = __builtin_amdgcn_rcpf(1.f + eb); rr[e] = fminf((1.f + eb) * __builtin_amdgcn_rcpf(1.f + ea), 1e20f); }
                    *(GAS v4u*)(Rb + row * DM + oc) = pack8(rr); *(GAS v4u*)(Gb + row * DM + oc) = pack8(gg);
                }
            return false;
        }
        bf16* dstb = (bf16*)(ws + (g == 0 ? WS_XA : g == 1 ? WS_ZA : g == 4 ? WS_V : WS_ZB));
        float* vout = smp ? out + O_VS - (size_t)MP * DM : out + O_VP;
#pragma unroll
        for (int ai = 0; ai < 2; ++ai)
#pragma unroll
            for (int m = 0; m < 4; ++m) {
                const int rowi = row0 + ai * 128 + m * 16; const size_t row = (size_t)rowi;
#pragma unroll
                for (int bj = 0; bj < 2; ++bj) {
                    float v[8];
#pragma unroll
                    for (int e = 0; e < 8; ++e) v[e] = acc[ai][bj][m][e >> 2][e & 3];
                    if (g == 0) {
                        const int t = smp ? (rowi & 63) : (rowi & 2047); const int T = smp ? 64 : 2048;
                        if (t >= T - 3) { const int b = smp ? ((rowi - MP) >> 6) : (rowi >> 11);
                            GAS f32x4* o = (GAS f32x4*)(out + (smp ? O_CS : O_CP) + (size_t)(b * 3 + (t - (T - 3))) * DM + cb + bj * 32);
                            o[0] = (f32x4){v[0], v[1], v[2], v[3]}; o[1] = (f32x4){v[4], v[5], v[6], v[7]}; }
                    } else if (g == 4) {
                        GAS f32x4* o = (GAS f32x4*)(vout + row * DM + cb + bj * 32); o[0] = (f32x4){v[0], v[1], v[2], v[3]}; o[1] = (f32x4){v[4], v[5], v[6], v[7]};
                    } else if (g == 1 || g == 5) {
#pragma unroll
                        for (int e = 0; e < 8; ++e) v[e] = v[e] * sigm(v[e]);
                    } else if (g == 6 || g == 7) {
#pragma unroll
                        for (int e = 0; e < 8; ++e) v[e] = sigm(v[e]);
                    }
                    *(GAS v4u*)(dstb + row * DM + cb + bj * 32) = pack8(v);
                }
            }
        return false;
    }
};
struct EpiProj {
    static constexpr bool PERM = true;
    const bf16* GA; const bf16* GB; bf16* MB;
    __device__ __forceinline__ bool operator()(pg8::f32x4 (&acc)[2][2][4][2], const pg8::Unit& u, int wr, int wc, int fr, int fq) const {
        const int row0 = u.pm * 256 + wr * 64 + fr, col0 = u.pn * 256 + wc * 32 + 8 * fq;
        v4u gA[2][2][2], gB[2][2][2];
#define LOADG(P, G, buf, q) do { _Pragma("unroll") for (int m = 0; m < 2; ++m) _Pragma("unroll") for (int bj = 0; bj < 2; ++bj) \
            G[buf][m][bj] = *(const GAS v4u*)((P) + (size_t)(row0 + ((q) >> 1) * 128 + (2 * ((q) & 1) + m) * 16) * DM + col0 + bj * 128); } while (0)
#define GV(e) ((e) & 1 ? bfhi(w_[(e) >> 1]) : bflo(w_[(e) >> 1]))
        if (u.kp == 0) {
            LOADG(GA, gA, 0, 0); __builtin_amdgcn_sched_barrier(0);
#pragma unroll
            for (int q = 0; q < 4; ++q) { const int ai = q >> 1, mh = q & 1, cb_ = q & 1;
                if (q + 1 < 4) LOADG(GA, gA, cb_ ^ 1, q + 1);
                __builtin_amdgcn_sched_barrier(0);
#pragma unroll
                for (int m = 0; m < 2; ++m)
#pragma unroll
                    for (int bj = 0; bj < 2; ++bj) { const unsigned w_[4] = {gA[cb_][m][bj].x, gA[cb_][m][bj].y, gA[cb_][m][bj].z, gA[cb_][m][bj].w};
#pragma unroll
                        for (int e = 0; e < 8; ++e) acc[ai][bj][2 * mh + m][e >> 2][e & 3] *= GV(e); }
                __builtin_amdgcn_sched_barrier(0);
            }
            return true;
        }
        LOADG(GB, gB, 0, 0); __builtin_amdgcn_sched_barrier(0);
#pragma unroll
        for (int q = 0; q < 4; ++q) { const int ai = q >> 1, mh = q & 1, cb_ = q & 1;
            if (q + 1 < 4) LOADG(GB, gB, cb_ ^ 1, q + 1);
            __builtin_amdgcn_sched_barrier(0);
#pragma unroll
            for (int m = 0; m < 2; ++m)
#pragma unroll
                for (int bj = 0; bj < 2; ++bj) { const unsigned w_[4] = {gB[cb_][m][bj].x, gB[cb_][m][bj].y, gB[cb_][m][bj].z, gB[cb_][m][bj].w};
                    float v[8];
#pragma unroll
                    for (int e = 0; e < 8; ++e) v[e] = acc[ai][bj][2 * mh + m][e >> 2][e & 3] * GV(e);
                    *(GAS v4u*)(MB + (size_t)(row0 + ai * 128 + (2 * mh + m) * 16) * DM + col0 + bj * 128) = pack8(v); }
            __builtin_amdgcn_sched_barrier(0);
        }
#undef LOADG
#undef GV
        return false;
    }
};
struct EpiOut {
    static constexpr bool PERM = false;
    const float* xp; const float* xs; float* out;
    __device__ __forceinline__ bool operator()(pg8::f32x4 (&acc)[2][2][4][2], const pg8::Unit& u, int wr, int wc, int fr, int fq) const {
        const int row0 = u.pm * 256 + wr * 64 + fr, col0 = u.pn * 256 + wc * 32 + 4 * fq;
        const float* xb = (u.pm >= 256) ? xs - (size_t)MP * DM : xp;
        f32x4 xv[2][2][2][2];
#define LOADX(buf, q) do { _Pragma("unroll") for (int m = 0; m < 2; ++m) _Pragma("unroll") for (int bj = 0; bj < 2; ++bj) _Pragma("unroll") for (int n = 0; n < 2; ++n) \
            xv[buf][m][bj][n] = *(const GAS f32x4*)(xb + (size_t)(row0 + ((q) >> 1) * 128 + (2 * ((q) & 1) + m) * 16) * DM + col0 + bj * 128 + n * 16); } while (0)
        LOADX(0, 0); __builtin_amdgcn_sched_barrier(0);
#pragma unroll
        for (int q = 0; q < 4; ++q) { const int ai = q >> 1, mh = q & 1, cb_ = q & 1;
            if (q + 1 < 4) LOADX(cb_ ^ 1, q + 1);
            __builtin_amdgcn_sched_barrier(0);
#pragma unroll
            for (int m = 0; m < 2; ++m)
#pragma unroll
                for (int bj = 0; bj < 2; ++bj)
#pragma unroll
                    for (int n = 0; n < 2; ++n) { const pg8::f32x4 a = acc[ai][bj][2 * mh + m][n]; const f32x4 x = xv[cb_][m][bj][n];
                        *(GAS f32x4*)(out + (size_t)(row0 + ai * 128 + (2 * mh + m) * 16) * DM + col0 + bj * 128 + n * 16) = (f32x4){x.x + a.x, x.y + a.y, x.z + a.z, x.w + a.w}; }
            __builtin_amdgcn_sched_barrier(0);
        }
#undef LOADX
        return false;
    }
};

constexpr int L_XCB = 0, L_RAW = 17408, L_HALO = L_RAW + 17408, L_BB = L_HALO + 1024;
static_assert(L_BB + 33792 <= RING_BYTES, "LRU LDS map");
__device__ __forceinline__ void lru_unit(Frame& F, int seq, int n) {
    const bool smp = seq >= 32; const int b = smp ? seq - 32 : seq; const int T = smp ? DSEQ : SEQ;
    const size_t rowbase = smp ? (size_t)MP + (size_t)b * DSEQ : (size_t)b * SEQ;
    int tid = F.tid; asm volatile("" : "+v"(tid));
    const int lane = tid & 63, w = F.wave;
    LAS unsigned char* L = F.lds;
    LAS bf16* XCB = (LAS bf16*)(L + L_XCB); LAS bf16* RAW = (LAS bf16*)(L + L_RAW); LAS bf16* HALO = (LAS bf16*)(L + L_HALO); LAS float* BB = (LAS float*)(L + L_BB);
    const bf16* XA = (const bf16*)(F.ws + WS_XA); const bf16* ZA = (const bf16*)(F.ws + WS_ZA); bf16* YAB = (bf16*)(F.ws + WS_YAB);
    const int ct = tid >> 4, cg = tid & 15, c0 = 128 * n + 8 * cg;
    float cw[4][8], cbias[8];
#pragma unroll
    for (int e = 0; e < 8; ++e) { cbias[e] = F.in[9][c0 + e];
#pragma unroll
        for (int j = 0; j < 4; ++j) cw[j][e] = F.in[8][j * DM + c0 + e]; }
    const int dl = 16 * w + (lane & 15), tq = lane >> 4, dg = 128 * n + dl;
    const float brg = F.in[11][dg], big = F.in[13][dg];
    float nsp; { const float x = -F.in[14][dg]; const float sp = fmaxf(x, 0.f) + log1pf(expf(-fabsf(x))); nsp = -8.f * LOG2E * sp; }
    bf16x8 Br[4], Bi[4];
    { const bf16* WG = (const bf16*)(F.ws + WS_WG) + (size_t)(2 * n) * 16384;
#pragma unroll
      for (int kk = 0; kk < 4; ++kk) { Br[kk] = *(const GAS bf16x8*)(WG + (size_t)dl * 128 + 32 * kk + 8 * tq); Bi[kk] = *(const GAS bf16x8*)(WG + 16384 + (size_t)dl * 128 + 32 * kk + 8 * tq); } }
    float hc = smp ? F.in[5][b * DM + dg] : 0.f;
    if (tid < 48) { const int hr = tid >> 4; float x[8];
        if (smp) { const GAS f32x4* sp_ = (const GAS f32x4*)(F.in[4] + (size_t)(b * 3 + hr) * DM + c0); const f32x4 s0 = sp_[0], s1 = sp_[1];
            x[0] = s0.x; x[1] = s0.y; x[2] = s0.z; x[3] = s0.w; x[4] = s1.x; x[5] = s1.y; x[6] = s1.z; x[7] = s1.w; }
        else {
#pragma unroll
            for (int e = 0; e < 8; ++e) x[e] = 0.f; }
        *(LAS v4u*)(HALO + hr * 136 + 8 * cg) = pack8(x); }
    v4u xr0, xr1; unsigned short zc[16], zn[16];
    const bf16* xsrc = XA + (rowbase + ct) * DM + c0; const bf16* zsrc = ZA + (rowbase + 4 * tq) * DM + dg;
    xr0 = *(const GAS v4u*)(xsrc); xr1 = *(const GAS v4u*)(xsrc + (size_t)32 * DM);
#pragma unroll
    for (int i = 0; i < 16; ++i) zc[i] = *(const GAS unsigned short*)(zsrc + (size_t)(16 * (i >> 2) + (i & 3)) * DM);
    for (int t0 = 0; t0 < T; t0 += 64) {
        *(LAS v4u*)(RAW + ct * 136 + 8 * cg) = xr0; *(LAS v4u*)(RAW + (ct + 32) * 136 + 8 * cg) = xr1;
        { const int tn = (t0 + 64 < T) ? t0 + 64 : t0;
          xr0 = *(const GAS v4u*)(xsrc + (size_t)tn * DM); xr1 = *(const GAS v4u*)(xsrc + (size_t)(tn + 32) * DM);
#pragma unroll
          for (int i = 0; i < 16; ++i) zn[i] = *(const GAS unsigned short*)(zsrc + (size_t)(tn + 16 * (i >> 2) + (i & 3)) * DM); }
        __syncthreads();
#pragma unroll
        for (int p = 0; p < 2; ++p) {
            const int t = ct + 32 * p;
            float a[8];
#pragma unroll
            for (int e = 0; e < 8; ++e) a[e] = cbias[e];
#pragma unroll
            for (int j = 0; j < 4; ++j) {
                const int tr = t + j - 3;
                const v4u q = (tr >= 0) ? *(const LAS v4u*)(RAW + tr * 136 + 8 * cg) : *(const LAS v4u*)(HALO + (tr + 3) * 136 + 8 * cg);
                const float x[8] = {bflo(q.x), bfhi(q.x), bflo(q.y), bfhi(q.y), bflo(q.z), bfhi(q.z), bflo(q.w), bfhi(q.w)};
#pragma unroll
                for (int e = 0; e < 8; ++e) a[e] += x[e] * cw[j][e];
            }
            *(LAS f32x4*)(BB + t * 132 + 8 * cg) = (f32x4){a[0], a[1], a[2], a[3]}; *(LAS f32x4*)(BB + t * 132 + 8 * cg + 4) = (f32x4){a[4], a[5], a[6], a[7]};
            *(LAS v4u*)(XCB + t * 136 + 8 * cg) = pack8(a);
        }
        if (tid < 48) *(LAS v4u*)(HALO + (tid >> 4) * 136 + 8 * cg) = *(const LAS v4u*)(RAW + (61 + (tid >> 4)) * 136 + 8 * cg);
        __syncthreads();
        {
            pg8::f32x4 ar[4], ai_[4];
#pragma unroll
            for (int tt = 0; tt < 4; ++tt) { ar[tt] = (pg8::f32x4){0.f, 0.f, 0.f, 0.f}; ai_[tt] = (pg8::f32x4){0.f, 0.f, 0.f, 0.f}; }
#pragma unroll
            for (int tt = 0; tt < 4; ++tt)
#pragma unroll
                for (int kk = 0; kk < 4; ++kk) {
                    const bf16x8 af = *(const LAS bf16x8*)(XCB + (16 * tt + (lane & 15)) * 136 + 32 * kk + 8 * tq);
                    ar[tt] = __builtin_amdgcn_mfma_f32_16x16x32_bf16(af, Br[kk], ar[tt], 0, 0, 0);
                    ai_[tt] = __builtin_amdgcn_mfma_f32_16x16x32_bf16(af, Bi[kk], ai_[tt], 0, 0, 0);
                }
            float A[4][4], B[4][4];
#pragma unroll
            for (int tt = 0; tt < 4; ++tt)
#pragma unroll
                for (int rg = 0; rg < 4; ++rg) {
                    const int t = 16 * tt + 4 * tq + rg;
                    const float r = sigm(ar[tt][rg] + brg), ig = sigm(ai_[tt][rg] + big);
                    const float av = __builtin_amdgcn_exp2f(r * nsp);
                    float mult = __builtin_amdgcn_sqrtf(fmaxf(__builtin_fmaf(-av, av, 1.f), 0.f));
                    if (!smp && (t0 + t) == 0) mult = 1.f;
                    A[tt][rg] = av; B[tt][rg] = mult * ig * BB[t * 132 + dl];
                }
#pragma unroll
            for (int tt = 0; tt < 4; ++tt)
#pragma unroll
                for (int rg = 1; rg < 4; ++rg) { B[tt][rg] = A[tt][rg] * B[tt][rg - 1] + B[tt][rg]; A[tt][rg] = A[tt][rg] * A[tt][rg - 1]; }
            float EA[4], EB[4], TA[4], TB[4];
#pragma unroll
            for (int tt = 0; tt < 4; ++tt) {
                float SA = A[tt][3], SB = B[tt][3];
                { const float pA = __shfl_up(SA, 16), pB = __shfl_up(SB, 16); if (tq >= 1) { SB = SA * pB + SB; SA = SA * pA; } }
                { const float pA = __shfl_up(SA, 32), pB = __shfl_up(SB, 32); if (tq >= 2) { SB = SA * pB + SB; SA = SA * pA; } }
                { const float pA = __shfl_up(SA, 16), pB = __shfl_up(SB, 16); EA[tt] = (tq >= 1) ? pA : 1.f; EB[tt] = (tq >= 1) ? pB : 0.f; }
                TA[tt] = __shfl(SA, (lane & 15) + 48); TB[tt] = __shfl(SB, (lane & 15) + 48);
            }
            const size_t r0 = rowbase + t0 + 4 * tq;
#pragma unroll
            for (int tt = 0; tt < 4; ++tt) {
                const float hin = EA[tt] * hc + EB[tt];
#pragma unroll
                for (int rg = 0; rg < 4; ++rg) { const float h = A[tt][rg] * hin + B[tt][rg];
                    const float y = h * bf2f(zc[4 * tt + rg]);
                    *(GAS unsigned short*)(YAB + (r0 + 16 * tt + rg) * (2 * DM) + dg) = (unsigned short)(pk2(y, 0.f) & 0xffffu); }
                hc = TA[tt] * hc + TB[tt];
            }
#pragma unroll
            for (int i = 0; i < 16; ++i) zc[i] = zn[i];
        }
    }
    if (tq == 0) F.out[(smp ? O_LS : O_LP) + (size_t)b * DM + dg] = hc;
    __syncthreads();
}

#define KSWZ(row, colB) ((row) * 256 + ((colB) ^ (((row) & 7) << 4)))
#define SBAR() __builtin_amdgcn_sched_barrier(0)
constexpr int A_V = 0, A_K = 32768, A_TB = 65536, A_WS = 66560;
__device__ __forceinline__ int crow(int r, int hi) { return (r & 3) + 8 * (r >> 2) + 4 * hi; }
__device__ __forceinline__ int v_st(int k, int c) { const int kk = (k & ~0xC) | ((k & 4) << 1) | ((k & 8) >> 1); return ((kk >> 3) * 4 + (c >> 5)) * 512 + ((kk & 7) * 32 + (c & 31)) * 2; }
__device__ __forceinline__ int v_rd_base(int lane) { return ((lane & 3) << 3) | (((lane >> 2) & 3) << 6) | (((lane >> 4) & 1) << 5) | (((lane >> 5) & 1) << 8); }
constexpr int v_rd_off(int d0, int ks, int half) { return d0 * 512 + ks * 4096 + half * 2048; }
template <int OFF> __device__ __forceinline__ s16x4 tr_read(int vb) {
    s16x4 r; asm volatile("ds_read_b64_tr_b16 %0, %1 offset:%2" : "=&v"(r) : "v"(vb), "i"(OFF) : "memory"); return r;
}
#define PKV(L, H) (bf16x8){L[0], L[1], L[2], L[3], H[0], H[1], H[2], H[3]}
template <int D0, int NKS> __device__ __forceinline__ void pv_one(f32x16& od, int vb, bf16x8 pa0, bf16x8 pa1, bf16x8 pa2, bf16x8 pa3) {
    const s16x4 l0 = tr_read<v_rd_off(D0, 0, 0)>(vb), h0 = tr_read<v_rd_off(D0, 0, 1)>(vb), l1 = tr_read<v_rd_off(D0, 1, 0)>(vb), h1 = tr_read<v_rd_off(D0, 1, 1)>(vb);
    if constexpr (NKS == 4) {
        const s16x4 l2 = tr_read<v_rd_off(D0, 2, 0)>(vb), h2 = tr_read<v_rd_off(D0, 2, 1)>(vb), l3 = tr_read<v_rd_off(D0, 3, 0)>(vb), h3 = tr_read<v_rd_off(D0, 3, 1)>(vb);
        asm volatile("s_waitcnt lgkmcnt(0)" ::: "memory"); SBAR();
        od = __builtin_amdgcn_mfma_f32_32x32x16_bf16(pa0, PKV(l0, h0), od, 0, 0, 0);
        od = __builtin_amdgcn_mfma_f32_32x32x16_bf16(pa1, PKV(l1, h1), od, 0, 0, 0);
        od = __builtin_amdgcn_mfma_f32_32x32x16_bf16(pa2, PKV(l2, h2), od, 0, 0, 0);
        od = __builtin_amdgcn_mfma_f32_32x32x16_bf16(pa3, PKV(l3, h3), od, 0, 0, 0);
    } else {
        asm volatile("s_waitcnt lgkmcnt(0)" ::: "memory"); SBAR();
        od = __builtin_amdgcn_mfma_f32_32x32x16_bf16(pa0, PKV(l0, h0), od, 0, 0, 0);
        od = __builtin_amdgcn_mfma_f32_32x32x16_bf16(pa1, PKV(l1, h1), od, 0, 0, 0);
    }
}
__device__ __forceinline__ bf16x8 tobf8(f32x8 x) { v4u w = {pk2(x[0], x[1]), pk2(x[2], x[3]), pk2(x[4], x[5]), pk2(x[6], x[7])}; return __builtin_bit_cast(bf16x8, w); }
__device__ __forceinline__ bf16x8 tobf8(bf16x8 x) { return x; }
__device__ __forceinline__ int rel_bucket(int rel) {
    const int n = rel < 0 ? -rel : rel; int bk;
    if (n < 8) bk = n; else { int k = (31 - __builtin_clz((unsigned)(n * n))) - 6; bk = 8 + k; if (bk > 15) bk = 15; }
    return bk + (rel > 0 ? 16 : 0);
}

template <bool SMP>
__device__ __forceinline__ void attn_unit(Frame& F, int b, int h, int qb, float lam, float mshift) {
    using ST = typename std::conditional<SMP, f32x8, bf16x8>::type;
    int tid = F.tid; asm volatile("" : "+v"(tid));
    const int lane = tid & 63, w = F.wave, r32 = lane & 31, hi = lane >> 5;
    const int m = w >> 2, rb = SMP ? ((w >> 1) & 1) : (w & 3), kh = SMP ? (w & 1) : 0;
    const int NT = SMP ? 66 : 2 * qb + 2;
    const int LT = SMP ? 64 : NT - 1;
    const int qpos0 = SMP ? PAST : 128 * qb;
    const size_t qrow0 = SMP ? (size_t)MP + (size_t)b * DSEQ : (size_t)b * SEQ + 128 * qb;
    const int qpw = qpos0 + 32 * rb, cw = qpw >> 6;
    LAS unsigned char* L = F.lds;
    LAS float* TB = (LAS float*)(L + A_TB); LAS float* WSF = (LAS float*)(L + A_WS) + w * 64;
    const bf16* QB = (const bf16*)(F.ws + WS_Q); const bf16* KB = (const bf16*)(F.ws + WS_K); const bf16* VB = (const bf16*)(F.ws + WS_V); const bf16* ZB = (const bf16*)(F.ws + WS_ZB);
    bf16* YAB = (bf16*)(F.ws + WS_YAB);
    if (tid < 255) TB[tid] = F.in[17][rel_bucket(tid - 191) * NH + h] * LOG2E - __builtin_bit_cast(float, F.MISC[17]);
    bf16x8 qr[4];
    { const bf16* Qw = QB + (qrow0 + 32 * rb + r32) * DM + h * 128 + m * 64 + hi * 8;
#pragma unroll
      for (int d0 = 0; d0 < 4; ++d0) qr[d0] = *(const GAS bf16x8*)(Qw + d0 * 16); }
    const int sr = tid >> 4, sc = (tid & 15) * 8, vst0 = v_st(sr, sc), vst1 = v_st(32 + sr, sc);
    const int vb0 = (int)(uintptr_t)(L + A_V) + v_rd_base(lane) + kh * 8192;
    struct Slot { ST v0, v1, k0, k1; } sA, sB;
    const float* ck = F.in[2] + ((size_t)b * PAST * NH + h) * 128 + sc; const float* cv = F.in[3] + ((size_t)b * PAST * NH + h) * 128 + sc;
    const float* nk = F.out + O_KS + ((size_t)b * DSEQ * NH + h) * 128 + sc; const float* nv = F.out + O_VS + ((size_t)b * DSEQ * NH + h) * 128 + sc;
    const bf16* pk = KB + ((size_t)b * SEQ) * DM + h * 128 + sc; const bf16* pvp = VB + ((size_t)b * SEQ) * DM + h * 128 + sc;
#define SLOAD(s, j) do { if constexpr (SMP) { const float* kp_ = ((j) < 64) ? ck + (size_t)(j) * 64 * DM : nk; const float* vp_ = ((j) < 64) ? cv + (size_t)(j) * 64 * DM : nv; \
        s.v0 = *(const GAS f32x8*)(vp_ + (size_t)sr * DM); s.v1 = *(const GAS f32x8*)(vp_ + (size_t)(32 + sr) * DM); \
        s.k0 = *(const GAS f32x8*)(kp_ + (size_t)sr * DM); s.k1 = *(const GAS f32x8*)(kp_ + (size_t)(32 + sr) * DM); } \
      else { const bf16* kp_ = pk + (size_t)(j) * 64 * DM; const bf16* vp_ = pvp + (size_t)(j) * 64 * DM; \
        s.v0 = *(const GAS ST*)(vp_ + (size_t)sr * DM); s.v1 = *(const GAS ST*)(vp_ + (size_t)(32 + sr) * DM); s.k0 = *(const GAS ST*)(kp_ + (size_t)sr * DM); s.k1 = *(const GAS ST*)(kp_ + (size_t)(32 + sr) * DM); } } while (0)
#define SWRITE(bo, s) do { *(LAS bf16x8*)(L + A_V + (bo) + vst0) = tobf8(s.v0); *(LAS bf16x8*)(L + A_V + (bo) + vst1) = tobf8(s.v1); \
        *(LAS bf16x8*)(L + A_K + (bo) + KSWZ(sr, sc * 2)) = tobf8(s.k0); *(LAS bf16x8*)(L + A_K + (bo) + KSWZ(32 + sr, sc * 2)) = tobf8(s.k1); } while (0)
    f32x16 o[4]; float l_reg = 0.f;
#pragma unroll
    for (int d = 0; d < 4; ++d)
#pragma unroll
        for (int r = 0; r < 16; ++r) o[d][r] = 0.f;
#define ITER(j, s, bo) do { \
        if constexpr (SMP) asm volatile("s_waitcnt vmcnt(8)" ::: "memory"); else asm volatile("s_waitcnt vmcnt(4)" ::: "memory"); \
        SWRITE(bo, s); __syncthreads(); \
        { const int jn_ = ((j) + 2 < LT) ? (j) + 2 : LT; const int jm_ = TMAP(jn_); SLOAD(s, jm_); } \
        if ((j) <= cw) { \
            f32x16 p0, p1; \
            const int jt_ = TMAP(j); \
            const int kofs = 64 * jt_ + 32 * kh; \
            if (jt_ >= cw - 2) { const int ib = kofs - (qpw + r32) + 191 + 4 * hi; \
                _Pragma("unroll") for (int r = 0; r < 16; ++r) { p0[r] = TB[ib + (r & 3) + 8 * (r >> 2)]; if constexpr (!SMP) p1[r] = TB[ib + 32 + (r & 3) + 8 * (r >> 2)]; } } \
            else { const float cf = TB[63]; _Pragma("unroll") for (int r = 0; r < 16; ++r) { p0[r] = cf; if constexpr (!SMP) p1[r] = cf; } } \
            const LAS unsigned char* Ks = L + A_K + (bo); \
            _Pragma("unroll") for (int d0 = 0; d0 < 4; ++d0) { const int cbb = (m * 64 + d0 * 16 + hi * 8) * 2; \
                const bf16x8 b0 = *(const LAS bf16x8*)(Ks + KSWZ(32 * kh + r32, cbb)); \
                p0 = __builtin_amdgcn_mfma_f32_32x32x16_bf16(b0, qr[d0], p0, 0, 0, 0); \
                if constexpr (!SMP) { const bf16x8 b1 = *(const LAS bf16x8*)(Ks + KSWZ(32 + r32, cbb)); p1 = __builtin_amdgcn_mfma_f32_32x32x16_bf16(b1, qr[d0], p1, 0, 0, 0); } } \
            float ps = 0.f; \
            _Pragma("unroll") for (int r = 0; r < 16; ++r) { p0[r] = __builtin_amdgcn_exp2f(p0[r]); ps += p0[r]; } \
            if constexpr (!SMP) { _Pragma("unroll") for (int r = 0; r < 16; ++r) { p1[r] = __builtin_amdgcn_exp2f(p1[r]); ps += p1[r]; } } \
            l_reg += ps; \
            bf16x8 pa0, pa1, pa2, pa3; \
            PK4(p0, 0, pa0); PK4(p0, 8, pa1); if constexpr (!SMP) { PK4(p1, 0, pa2); PK4(p1, 8, pa3); } else { pa2 = pa0; pa3 = pa1; } \
            SBAR(); \
            constexpr int NKS_ = SMP ? 2 : 4; \
            pv_one<0, NKS_>(o[0], vb0 + (bo), pa0, pa1, pa2, pa3); pv_one<1, NKS_>(o[1], vb0 + (bo), pa0, pa1, pa2, pa3); \
            pv_one<2, NKS_>(o[2], vb0 + (bo), pa0, pa1, pa2, pa3); pv_one<3, NKS_>(o[3], vb0 + (bo), pa0, pa1, pa2, pa3); \
        } } while (0)
#define PK4(P, BASE, OUT) do { unsigned a0 = pk2(P[BASE + 0], P[BASE + 1]), a1 = pk2(P[BASE + 2], P[BASE + 3]);   \
    unsigned b0_ = pk2(P[BASE + 4], P[BASE + 5]), b1_ = pk2(P[BASE + 6], P[BASE + 7]);                              \
    auto r0 = __builtin_amdgcn_permlane32_swap(a0, b0_, false, false); auto r1 = __builtin_amdgcn_permlane32_swap(a1, b1_, false, false); \
    v4u w_ = {r0[0], r1[0], r0[1], r1[1]}; OUT = __builtin_bit_cast(bf16x8, w_); } while (0)
    const int j0 = SMP ? (b * 8) % 65 : 0;
#define TMAP(i) (SMP ? (((i) + j0 >= 65) ? (i) + j0 - 65 : (i) + j0) : (i))
    { const int t0_ = TMAP(0), t1_ = TMAP(1); SLOAD(sA, t0_); SLOAD(sB, t1_); }
    for (int j = 0; j < NT; j += 2) {
        ITER(j, sA, 0);
        ITER(j + 1, sB, 16384);
    }
    asm volatile("s_waitcnt vmcnt(0)" ::: "memory");
#undef ITER
#undef TMAP
#undef PK4
#undef SLOAD
#undef SWRITE
    __syncthreads();
    { auto rr = __builtin_amdgcn_permlane32_swap(__float_as_uint(l_reg), __float_as_uint(l_reg), false, false); l_reg = __uint_as_float(rr[0]) + __uint_as_float(rr[1]); }
    LAS float* X = (LAS float*)L;
    bool active = true;
    if constexpr (SMP) {
        const int wp = w >> 1;
        if (kh == 1) {
#pragma unroll
            for (int r = 0; r < 16; ++r)
#pragma unroll
                for (int d0 = 0; d0 < 4; ++d0) X[((wp * 16 + r) * 4 + d0) * 64 + lane] = o[d0][r];
            WSF[r32] = l_reg;
        }
        __syncthreads();
        if (kh == 0) {
#pragma unroll
            for (int r = 0; r < 16; ++r)
#pragma unroll
                for (int d0 = 0; d0 < 4; ++d0) o[d0][r] += X[((wp * 16 + r) * 4 + d0) * 64 + lane];
            l_reg += WSF[64 + r32];
        }
        __syncthreads();
        active = (kh == 0);
    }
    const int rbq = rb;
    float fr_[16];
    if (active) {
        const float f = (m == 0 ? 1.f : __builtin_bit_cast(float, F.MISC[16])) / l_reg;
        if (hi == 0) WSF[r32] = f;
        LDS_WAIT();
#pragma unroll
        for (int r = 0; r < 16; ++r) fr_[r] = WSF[crow(r, hi)];
        if (m == 1) {
#pragma unroll
            for (int r = 0; r < 16; ++r)
#pragma unroll
                for (int d0 = 0; d0 < 4; ++d0) X[((rbq * 16 + r) * 4 + d0) * 64 + lane] = o[d0][r] * fr_[r];
        }
    }
    __syncthreads();
    if (active && m == 0) {
#pragma unroll
        for (int r = 0; r < 16; ++r)
#pragma unroll
            for (int d0 = 0; d0 < 4; ++d0) o[d0][r] = o[d0][r] * fr_[r] - X[((rbq * 16 + r) * 4 + d0) * 64 + lane];
    }
    __syncthreads();
    if (active && m == 0) {
#pragma unroll
        for (int r = 0; r < 16; ++r)
#pragma unroll
            for (int d0 = 0; d0 < 4; ++d0) X[(32 * rbq + crow(r, hi)) * 132 + 32 * d0 + r32] = o[d0][r];
    }
    __syncthreads();
    constexpr int R = SMP ? 64 : 128;
    if (tid < 4 * R) {
        const int row = tid >> 2, qd = tid & 3;
        const size_t grow = qrow0 + row;
        const bf16* zp = ZB + grow * DM + h * 128 + 32 * qd; bf16* yp = YAB + grow * (2 * DM) + DM + h * 128 + 32 * qd; const float* gp = F.in[22] + 32 * qd;
        v4u zz[4]; f32x4 gg[8];
#pragma unroll
        for (int i = 0; i < 4; ++i) zz[i] = *(const GAS v4u*)(zp + 8 * i);
#pragma unroll
        for (int i = 0; i < 8; ++i) gg[i] = *(const GAS f32x4*)(gp + 4 * i);
        float y[32]; float ss = 0.f;
#pragma unroll
        for (int i = 0; i < 8; ++i) { const f32x4 v = *(const LAS f32x4*)(X + row * 132 + 32 * qd + 4 * i); y[4 * i] = v.x; y[4 * i + 1] = v.y; y[4 * i + 2] = v.z; y[4 * i + 3] = v.w;
            ss += (v.x * v.x + v.y * v.y) + (v.z * v.z + v.w * v.w); }
        ss += __shfl_xor(ss, 1); ss += __shfl_xor(ss, 2);
        const float rinv = (1.f - LAM_INIT) / sqrtf(ss * (1.f / 128.f) + EPS);
        __builtin_amdgcn_sched_barrier(0);
#pragma unroll
        for (int i = 0; i < 4; ++i) { const v4u z = zz[i]; const f32x4 g0 = gg[2 * i], g1 = gg[2 * i + 1];
            float v[8];
            v[0] = y[8 * i] * rinv * g0.x * bflo(z.x); v[1] = y[8 * i + 1] * rinv * g0.y * bfhi(z.x); v[2] = y[8 * i + 2] * rinv * g0.z * bflo(z.y); v[3] = y[8 * i + 3] * rinv * g0.w * bfhi(z.y);
            v[4] = y[8 * i + 4] * rinv * g1.x * bflo(z.z); v[5] = y[8 * i + 5] * rinv * g1.y * bfhi(z.z); v[6] = y[8 * i + 6] * rinv * g1.z * bflo(z.w); v[7] = y[8 * i + 7] * rinv * g1.w * bfhi(z.w);
            *(GAS v4u*)(yp + 8 * i) = pack8(v); }
    }
    __syncthreads();
}

constexpr int P_SLOT = 32768, P_TB = 132096, P_WS = 133120;
static_assert(P_WS + 2048 <= LDS_BYTES, "prompt attention LDS map");
__device__ __forceinline__ void glds16(const void* gsrc, unsigned lds_dst) { unsigned keep;
    asm volatile("s_mov_b32 %0, m0\n\ts_mov_b32 m0, %2\n\ts_nop 0\n\tglobal_load_lds_dwordx4 %1, off\n\ts_mov_b32 m0, %0" : "=&s"(keep) : "v"(gsrc), "s"(lds_dst) : "memory"); }
#define WAIT_BAR0() asm volatile("s_waitcnt vmcnt(0) lgkmcnt(0)\n\ts_barrier" ::: "memory")
#define WAIT_BAR4() asm volatile("s_waitcnt vmcnt(4) lgkmcnt(0)\n\ts_barrier" ::: "memory")
__device__ __forceinline__ void attn_prompt(Frame& F, int b, int h, int qb, float lam, float mshift) {
    int tid = F.tid; asm volatile("" : "+v"(tid));
    const int lane = tid & 63, w = F.wave, r32 = lane & 31, hi = lane >> 5;
    const int m = w >> 2, rb = w & 3;
    const int NT = 2 * qb + 2;
    const size_t qrow0 = (size_t)b * SEQ + 128 * qb;
    const int qpw = 128 * qb + 32 * rb, cw = qpw >> 6;
    const bool vis = (cw == NT - 1);
    LAS unsigned char* L = F.lds;
    LAS float* TB = (LAS float*)(L + P_TB); LAS float* WSF = (LAS float*)(L + P_WS) + w * 64;
    const bf16* QB = (const bf16*)(F.ws + WS_Q); const bf16* ZB = (const bf16*)(F.ws + WS_ZB); bf16* YAB = (bf16*)(F.ws + WS_YAB);
    const bf16* Kt = (const bf16*)(F.ws + WS_K) + ((size_t)b * SEQ) * DM + h * 128; const bf16* Vt = (const bf16*)(F.ws + WS_V) + ((size_t)b * SEQ) * DM + h * 128;
    int ko[2], vo[2];
#pragma unroll
    for (int q = 0; q < 2; ++q) {
        const int row = 8 * w + 4 * q + (lane >> 4), cpos = lane & 15; ko[q] = row * DM + 8 * (cpos ^ (row & 7));
        const int c = w * 128 + q * 64 + lane, st = c >> 5, rowk = (c >> 2) & 7, cc = c & 3, kk = (st >> 2) * 8 + rowk, col = (st & 3) * 32 + cc * 8;
        const int k = (kk & ~0xC) | ((kk & 4) << 1) | ((kk & 8) >> 1); vo[q] = k * DM + col; }
    const unsigned lds0 = (unsigned)(uintptr_t)L;
    const unsigned dK = lds0 + w * 2048, dV = lds0 + 16384 + w * 2048;
#define DMA_TILE(j, so) do { const bf16* kb_ = Kt + (size_t)(j) * 64 * DM; const bf16* vb_ = Vt + (size_t)(j) * 64 * DM; \
        glds16(kb_ + ko[0], (unsigned)__builtin_amdgcn_readfirstlane(dK + (so))); glds16(kb_ + ko[1], (unsigned)__builtin_amdgcn_readfirstlane(dK + (so) + 1024)); \
        glds16(vb_ + vo[0], (unsigned)__builtin_amdgcn_readfirstlane(dV + (so))); glds16(vb_ + vo[1], (unsigned)__builtin_amdgcn_readfirstlane(dV + (so) + 1024)); } while (0)
    PTS_BEGIN(1, qb == 15 && F.pacc == 0); PTS_BEGIN(3, qb == 15 && F.pacc == 0);
    DMA_TILE(0, 0); DMA_TILE(1, P_SLOT);
    if (tid < 255) TB[tid] = F.in[17][rel_bucket(tid - 191) * NH + h] * LOG2E - __builtin_bit_cast(float, F.MISC[17]);
    bf16x8 qr[4];
    { const bf16* Qw = QB + (qrow0 + 32 * rb + r32) * DM + h * 128 + m * 64 + hi * 8;
#pragma unroll
      for (int d0 = 0; d0 < 4; ++d0) qr[d0] = *(const GAS bf16x8*)(Qw + d0 * 16); }
    const int vbase = (int)lds0 + 16384 + v_rd_base(lane);
    f32x16 o[4]; f32x16 ol;
    const bf16x8 ones = {0x3F80, 0x3F80, 0x3F80, 0x3F80, 0x3F80, 0x3F80, 0x3F80, 0x3F80};
#pragma unroll
    for (int d = 0; d < 4; ++d)
#pragma unroll
        for (int r = 0; r < 16; ++r) o[d][r] = 0.f;
#pragma unroll
    for (int r = 0; r < 16; ++r) ol[r] = 0.f;
    f32x16 pA0, pA1, pB0, pB1; bf16x8 pa0, pa1, pa2, pa3; f32x16 CF;
#define QKT(P0, P1, so, j) do { \
        const LAS unsigned char* Ks = L + (so); \
        { const int cbb = (m * 64 + hi * 8) * 2; \
          const bf16x8 b0 = *(const LAS bf16x8*)(Ks + KSWZ(r32, cbb)); const bf16x8 b1 = *(const LAS bf16x8*)(Ks + KSWZ(32 + r32, cbb)); \
          if ((j) >= cw - 2) { const int ib = 64 * (j) - (qpw + r32) + 191 + 4 * hi; \
              _Pragma("unroll") for (int r = 0; r < 16; ++r) { P0[r] = TB[ib + (r & 3) + 8 * (r >> 2)]; P1[r] = TB[ib + 32 + (r & 3) + 8 * (r >> 2)]; } \
              P0 = __builtin_amdgcn_mfma_f32_32x32x16_bf16(b0, qr[0], P0, 0, 0, 0); P1 = __builtin_amdgcn_mfma_f32_32x32x16_bf16(b1, qr[0], P1, 0, 0, 0); } \
          else { P0 = __builtin_amdgcn_mfma_f32_32x32x16_bf16(b0, qr[0], CF, 0, 0, 0); P1 = __builtin_amdgcn_mfma_f32_32x32x16_bf16(b1, qr[0], CF, 0, 0, 0); } } \
        _Pragma("unroll") for (int d0 = 1; d0 < 4; ++d0) { const int cbb = (m * 64 + d0 * 16 + hi * 8) * 2; \
            const bf16x8 b0 = *(const LAS bf16x8*)(Ks + KSWZ(r32, cbb)); const bf16x8 b1 = *(const LAS bf16x8*)(Ks + KSWZ(32 + r32, cbb)); \
            P0 = __builtin_amdgcn_mfma_f32_32x32x16_bf16(b0, qr[d0], P0, 0, 0, 0); P1 = __builtin_amdgcn_mfma_f32_32x32x16_bf16(b1, qr[d0], P1, 0, 0, 0); } } while (0)
#define PK4(P, BASE, OUT) do { unsigned a0 = pk2(P[BASE + 0], P[BASE + 1]), a1 = pk2(P[BASE + 2], P[BASE + 3]);   \
    unsigned b0_ = pk2(P[BASE + 4], P[BASE + 5]), b1_ = pk2(P[BASE + 6], P[BASE + 7]);                              \
    auto r0 = __builtin_amdgcn_permlane32_swap(a0, b0_, false, false); auto r1 = __builtin_amdgcn_permlane32_swap(a1, b1_, false, false); \
    v4u w_ = {r0[0], r1[0], r0[1], r1[1]}; OUT = __builtin_bit_cast(bf16x8, w_); } while (0)
#define FIN(P0, P1) do { PK4(P0, 0, pa0); PK4(P0, 8, pa1); PK4(P1, 0, pa2); PK4(P1, 8, pa3); } while (0)
#define EX2(X, i) X[i] = __builtin_amdgcn_exp2f(X[i])
#define VRD(D0, so, S) do { const int vb_ = vbase + (so); \
        S##l0 = tr_read<v_rd_off(D0, 0, 0)>(vb_); S##h0 = tr_read<v_rd_off(D0, 0, 1)>(vb_); S##l1 = tr_read<v_rd_off(D0, 1, 0)>(vb_); S##h1 = tr_read<v_rd_off(D0, 1, 1)>(vb_); \
        S##l2 = tr_read<v_rd_off(D0, 2, 0)>(vb_); S##h2 = tr_read<v_rd_off(D0, 2, 1)>(vb_); S##l3 = tr_read<v_rd_off(D0, 3, 0)>(vb_); S##h3 = tr_read<v_rd_off(D0, 3, 1)>(vb_); } while (0)
#define PVMF(D0, S, X, XB, DOEXP) do { \
        o[D0] = __builtin_amdgcn_mfma_f32_32x32x16_bf16(pa0, PKV(S##l0, S##h0), o[D0], 0, 0, 0); if (DOEXP) { EX2(X, XB + 0); EX2(X, XB + 1); } SBAR(); \
        o[D0] = __builtin_amdgcn_mfma_f32_32x32x16_bf16(pa1, PKV(S##l1, S##h1), o[D0], 0, 0, 0); if (DOEXP) { EX2(X, XB + 2); EX2(X, XB + 3); } SBAR(); \
        o[D0] = __builtin_amdgcn_mfma_f32_32x32x16_bf16(pa2, PKV(S##l2, S##h2), o[D0], 0, 0, 0); if (DOEXP) { EX2(X, XB + 4); EX2(X, XB + 5); } SBAR(); \
        o[D0] = __builtin_amdgcn_mfma_f32_32x32x16_bf16(pa3, PKV(S##l3, S##h3), o[D0], 0, 0, 0); if (DOEXP) { EX2(X, XB + 6); EX2(X, XB + 7); } SBAR(); } while (0)
#define LW(n) do { asm volatile("s_waitcnt lgkmcnt(" #n ")" ::: "memory"); SBAR(); } while (0)
#define PVALLH(so, X0, X1, DOEXP, H0, H1, H2, H3) do { \
        s16x4 val0, vah0, val1, vah1, val2, vah2, val3, vah3, vbl0, vbh0, vbl1, vbh1, vbl2, vbh2, vbl3, vbh3; \
        VRD(0, so, va); SBAR(); \
        ol = __builtin_amdgcn_mfma_f32_32x32x16_bf16(pa0, ones, ol, 0, 0, 0); ol = __builtin_amdgcn_mfma_f32_32x32x16_bf16(pa1, ones, ol, 0, 0, 0); \
        ol = __builtin_amdgcn_mfma_f32_32x32x16_bf16(pa2, ones, ol, 0, 0, 0); ol = __builtin_amdgcn_mfma_f32_32x32x16_bf16(pa3, ones, ol, 0, 0, 0); SBAR(); \
        VRD(1, so, vb); LW(8); PVMF(0, va, X0, 0, DOEXP); H0; SBAR(); \
        VRD(2, so, va); LW(8); PVMF(1, vb, X0, 8, DOEXP); H1; SBAR(); \
        VRD(3, so, vb); LW(8); PVMF(2, va, X1, 0, DOEXP); H2; SBAR(); \
        LW(0); PVMF(3, vb, X1, 8, DOEXP); H3; SBAR(); } while (0)
#define PVALL(so, X0, X1, DOEXP) PVALLH(so, X0, X1, DOEXP, (void)0, (void)0, (void)0, (void)0)
#define EXPALL(X0, X1) do { _Pragma("unroll") for (int r = 0; r < 16; ++r) { EX2(X0, r); EX2(X1, r); } } while (0)
    int s_prev = 0, s_cur = 0, s_next = P_SLOT, s_nn = 2 * P_SLOT;
#define ROT() do { s_prev = s_cur; s_cur = s_next; s_next = s_nn; s_nn = (s_nn == 3 * P_SLOT) ? 0 : s_nn + P_SLOT; } while (0)
    asm volatile("s_waitcnt vmcnt(0)" ::: "memory"); __syncthreads();
    { const float cf = TB[63];
#pragma unroll
      for (int r = 0; r < 16; ++r) CF[r] = cf; }
    { const int j2 = (2 < NT) ? 2 : NT - 1; DMA_TILE(j2, 2 * P_SLOT); }
    QKT(pA0, pA1, 0, 0); EXPALL(pA0, pA1);
    ROT();
#define STEP(C0, C1, R0, R1, j) do { \
        const int jn_ = ((j) + 2 < NT) ? (j) + 2 : NT - 1; const bf16* kb_ = Kt + (size_t)jn_ * 64 * DM; const bf16* vb_ = Vt + (size_t)jn_ * 64 * DM; \
        SBAR(); QKT(C0, C1, s_cur, j); FIN(R0, R1); SBAR(); \
        PVALLH(s_prev, C0, C1, true, \
            glds16(kb_ + ko[0], (unsigned)__builtin_amdgcn_readfirstlane(dK + s_nn)), glds16(kb_ + ko[1], (unsigned)__builtin_amdgcn_readfirstlane(dK + s_nn + 1024)), \
            glds16(vb_ + vo[0], (unsigned)__builtin_amdgcn_readfirstlane(dV + s_nn)), glds16(vb_ + vo[1], (unsigned)__builtin_amdgcn_readfirstlane(dV + s_nn + 1024))); \
        WAIT_BAR4(); ROT(); } while (0)
    for (int j = 1; j + 1 < NT; j += 2) {
        STEP(pB0, pB1, pA0, pA1, j);
        STEP(pA0, pA1, pB0, pB1, j + 1);
    }
    asm volatile("s_waitcnt vmcnt(0)" ::: "memory");
    SBAR(); if (vis) { QKT(pB0, pB1, s_cur, NT - 1); } FIN(pA0, pA1); SBAR();
    if (vis) { PVALL(s_prev, pB0, pB1, true); FIN(pB0, pB1); SBAR(); PVALL(s_cur, pB0, pB1, false); }
    else { PVALL(s_prev, pB0, pB1, false); }
#undef STEP
#undef ROT
#undef EXPALL
#undef PVALL
#undef PVALLH
#undef PVMF
#undef VRD
#undef LW
#undef EX2
#undef FIN
#undef PK4
#undef QKT
#undef DMA_TILE
    __syncthreads();
    PTS_END(1, qb == 15 && F.pt0 != 0 && F.pacc == 0); PTS_BEGIN(2, qb == 15 && F.pacc == 0);
    LAS float* X = (LAS float*)L;
    int tid2 = tid; asm volatile("" : "+v"(tid2));
    const int erow = tid2 >> 3, eoc = tid2 & 7;
    v4u zz[4]; f32x4 gg[4];
    { const bf16* zp = ZB + (qrow0 + erow) * DM + h * 128 + 8 * eoc; const float* gp = F.in[22] + 8 * eoc;
#pragma unroll
      for (int i = 0; i < 4; ++i) zz[i] = *(const GAS v4u*)(zp + (size_t)(i >> 1) * 64 * DM + 64 * (i & 1));
#pragma unroll
      for (int i = 0; i < 4; ++i) gg[i] = *(const GAS f32x4*)(gp + 64 * (i >> 1) + 4 * (i & 1)); }
    float fr_[16];
    { const float fm = (m == 0 ? 1.f : __builtin_bit_cast(float, F.MISC[16]));
#pragma unroll
      for (int r = 0; r < 16; ++r) fr_[r] = fm * __builtin_amdgcn_rcpf(ol[r]); }
    if (m == 1) {
#pragma unroll
        for (int r = 0; r < 16; ++r)
#pragma unroll
            for (int d0 = 0; d0 < 4; ++d0) X[((rb * 16 + r) * 4 + d0) * 64 + lane] = o[d0][r] * fr_[r];
    }
    __syncthreads();
    if (m == 0) {
#pragma unroll
        for (int r = 0; r < 16; ++r)
#pragma unroll
            for (int d0 = 0; d0 < 4; ++d0) o[d0][r] = o[d0][r] * fr_[r] - X[((rb * 16 + r) * 4 + d0) * 64 + lane];
    }
    __syncthreads();
    if (m == 0) {
#pragma unroll
        for (int r = 0; r < 16; ++r)
#pragma unroll
            for (int d0 = 0; d0 < 4; ++d0) X[(32 * rb + crow(r, hi)) * 132 + 32 * d0 + r32] = o[d0][r];
    }
    __syncthreads();
#pragma unroll
    for (int rr = 0; rr < 2; ++rr) {
        const int row = erow + 64 * rr;
        float y[16]; float ss = 0.f;
#pragma unroll
        for (int i = 0; i < 4; ++i) { const f32x4 v = *(const LAS f32x4*)(X + row * 132 + 64 * (i >> 1) + 8 * eoc + 4 * (i & 1)); y[4 * i] = v.x; y[4 * i + 1] = v.y; y[4 * i + 2] = v.z; y[4 * i + 3] = v.w;
            ss += (v.x * v.x + v.y * v.y) + (v.z * v.z + v.w * v.w); }
        ss += __shfl_xor(ss, 1); ss += __shfl_xor(ss, 2); ss += __shfl_xor(ss, 4);
        const float rinv = (1.f - LAM_INIT) / sqrtf(ss * (1.f / 128.f) + EPS);
        bf16* yp = YAB + (qrow0 + row) * (2 * DM) + DM + h * 128 + 8 * eoc;
#pragma unroll
        for (int j = 0; j < 2; ++j) { const v4u z = zz[2 * rr + j]; const f32x4 g0 = gg[2 * j], g1 = gg[2 * j + 1];
            float v[8];
            v[0] = y[8 * j] * rinv * g0.x * bflo(z.x); v[1] = y[8 * j + 1] * rinv * g0.y * bfhi(z.x); v[2] = y[8 * j + 2] * rinv * g0.z * bflo(z.y); v[3] = y[8 * j + 3] * rinv * g0.w * bfhi(z.y);
            v[4] = y[8 * j + 4] * rinv * g1.x * bflo(z.z); v[5] = y[8 * j + 5] * rinv * g1.y * bfhi(z.z); v[6] = y[8 * j + 6] * rinv * g1.z * bflo(z.w); v[7] = y[8 * j + 7] * rinv * g1.w * bfhi(z.w);
            *(GAS v4u*)(yp + 64 * j) = pack8(v); }
    }
    __syncthreads();
    PTS_END(2, qb == 15 && F.pt0 != 0 && F.pacc == 0); PTS_END(3, qb == 15 && F.pt0 != 0 && F.pacc == 0);
}

template <int PH>
__device__ __forceinline__ void sample_block(Frame& F, int c) {
    int tid = F.tid; asm volatile("" : "+v"(tid));
    const int lane = tid & 63, w = F.wave, r32 = lane & 31, hi = lane >> 5;
    const int rb = c >> 3, cb = c & 7, wr = w >> 2, wc = w & 3;
    constexpr int KA = (PH == 3) ? 2 * DM : DM, LDK = KA;
    const bf16* Ab = (PH == 3) ? (const bf16*)(F.ws + WS_YAB) : (const bf16*)(F.ws + WS_XN);
    const bf16* Bb = (PH == 3) ? (const bf16*)(F.ws + WS_WAB) : (const bf16*)(F.ws + WS_WOUT);
    LAS unsigned char* L = F.lds;
    const bf16* src[3]; int dst[3];
#pragma unroll
    for (int i = 0; i < 3; ++i) { const int p = tid + 512 * i, rowp = p >> 3, c8 = p & 7;
        src[i] = (rowp < 64) ? Ab + ((size_t)MP + 64 * rb + rowp) * LDK + 8 * c8 : Bb + (size_t)(128 * cb + rowp - 64) * LDK + 8 * c8;
        dst[i] = rowp * 144 + c8 * 16; }
    const int aoff = (32 * wr + r32) * 144 + hi * 16, boff = (64 + 32 * wc + r32) * 144 + hi * 16;
    f32x16 acc0, acc1;
#pragma unroll
    for (int r = 0; r < 16; ++r) { acc0[r] = 0.f; acc1[r] = 0.f; }
    v4u sA[3], sB[3];
#pragma unroll
    for (int i = 0; i < 3; ++i) { sA[i] = *(const GAS v4u*)(src[i]); sB[i] = *(const GAS v4u*)(src[i] + 64); }
#pragma unroll
    for (int i = 0; i < 3; ++i) *(LAS v4u*)(L + dst[i]) = sA[i];
#pragma unroll
    for (int i = 0; i < 3; ++i) sA[i] = *(const GAS v4u*)(src[i] + 128);
    __syncthreads();
    constexpr int BUFB = 192 * 144;
#define SB_STEP(k0, CUR, NXT, SW, SL) do { \
        bf16x8 a[4], b[4]; \
        _Pragma("unroll") for (int ks = 0; ks < 4; ++ks) { a[ks] = *(const LAS bf16x8*)(L + (CUR) + aoff + ks * 32); b[ks] = *(const LAS bf16x8*)(L + (CUR) + boff + ks * 32); } \
        if (PH == 3 && (k0) >= DM) { _Pragma("unroll") for (int ks = 0; ks < 4; ++ks) acc1 = __builtin_amdgcn_mfma_f32_32x32x16_bf16(a[ks], b[ks], acc1, 0, 0, 0); } \
        else { _Pragma("unroll") for (int ks = 0; ks < 4; ++ks) acc0 = __builtin_amdgcn_mfma_f32_32x32x16_bf16(a[ks], b[ks], acc0, 0, 0, 0); } \
        __builtin_amdgcn_sched_barrier(0); \
        _Pragma("unroll") for (int i = 0; i < 3; ++i) *(LAS v4u*)(L + (NXT) + dst[i]) = SW[i]; \
        { const int kn_ = ((k0) + 192 < KA) ? (k0) + 192 : KA - 64; _Pragma("unroll") for (int i = 0; i < 3; ++i) SW[i] = *(const GAS v4u*)(src[i] + kn_); } \
        __syncthreads(); } while (0)
    for (int k0 = 0; k0 < KA; k0 += 128) {
        SB_STEP(k0, 0, BUFB, sB, sA);
        SB_STEP(k0 + 64, BUFB, 0, sA, sB);
    }
#undef SB_STEP
    const size_t orow0 = (size_t)MP + 64 * rb + 32 * wr; const int ocol = 128 * cb + 32 * wc + r32;
    if (PH == 3) {
        const bf16* GA = (const bf16*)(F.ws + WS_GA); const bf16* GB = (const bf16*)(F.ws + WS_GB); bf16* MB = (bf16*)(F.ws + WS_XN);
        unsigned short ga[16], gb[16];
#pragma unroll
        for (int r = 0; r < 16; ++r) { const size_t off = (orow0 + crow(r, hi)) * DM + ocol; ga[r] = *(const GAS unsigned short*)(GA + off); gb[r] = *(const GAS unsigned short*)(GB + off); }
        __builtin_amdgcn_sched_barrier(0);
#pragma unroll
        for (int r = 0; r < 16; ++r) { const float v = bf2f(gb[r]) * (bf2f(ga[r]) * acc0[r] + acc1[r]);
            *(GAS unsigned short*)(MB + (orow0 + crow(r, hi)) * DM + ocol) = (unsigned short)(pk2(v, 0.f) & 0xffffu); }
    } else {
        const float* xs = F.in[1] - (size_t)MP * DM;
        float xv[16];
#pragma unroll
        for (int r = 0; r < 16; ++r) xv[r] = *(const GAS float*)(xs + (orow0 + crow(r, hi)) * DM + ocol);
        __builtin_amdgcn_sched_barrier(0);
#pragma unroll
        for (int r = 0; r < 16; ++r) *(GAS float*)(F.out + (orow0 + crow(r, hi)) * DM + ocol) = xv[r] + acc0[r];
    }
}

struct Args { const float* in[26]; float* out; unsigned char* ws; int ph_lo, ph_hi, li, pad; };
__global__ void __launch_bounds__(NWAVES * 64, 2) skel_fwd(Args args) {
    extern __shared__ __attribute__((aligned(16))) unsigned char lds[];
    Frame F;
    F.lds = (LAS unsigned char*)lds;
    F.MISC = (volatile LAS unsigned*)(F.lds + MISC_OFF);
    F.tid = threadIdx.x; F.lane = F.tid & 63; F.wave = __builtin_amdgcn_readfirstlane(F.tid >> 6);
    F.G = gridDim.x; { const int bx = blockIdx.x; F.vcu = (F.G % 8 == 0) ? (bx % 8) * (F.G / 8) + bx / 8 : bx; }
    F.ws = args.ws; F.out = args.out; F.ctl = (gu32*)(args.ws + WS_CTL); F.pt0 = 0; F.pacc = 0;
#pragma unroll
    for (int i = 0; i < 26; ++i) F.in[i] = args.in[i];
    for (int u = F.tid; u < (LDS_BYTES - LDSCTL_OFF) / 4; u += NWAVES * 64) ((LAS unsigned*)(F.lds + LDSCTL_OFF))[u] = 0u;
    __syncthreads();
    XcdBarrier bar; bar.bar = (unsigned*)(F.ctl + CW_BAR); bar.x = 0; bar.st = nullptr;
    if (N_LAUNCHES == 1) bar = xcd_barrier_post((unsigned*)(F.ctl + CW_BAR), F.MISC + 8);
#define GRID_BAR() do { if (N_LAUNCHES == 1) xcd_barrier(bar); } while (0)
#define GROUP_BAR(k) do { if (N_LAUNCHES == 1) { if (F.G == 256) group_barrier((unsigned*)(F.ctl + CW_BAR), (unsigned*)(F.ctl + CW_GRP) + ((k) * 8 + (F.vcu >> 5)) * 16, 32u, F.tid == 0); else xcd_barrier(bar); } } while (0)
    const int lo = args.ph_lo, hi = args.ph_hi;
#define IN(k) (lo <= (k) && (k) < hi)
#define BOTH(k) (IN(k) && IN((k) + 1))

    if (IN(0)) { for (int rep = 0; rep < (PROBE_DUP == 7 ? 2 : 1); ++rep) p0_prologue(F); if (BOTH(0)) GRID_BAR(); }

    if (IN(1)) {
        pg8::Gemm g{(const bf16*)(F.ws + WS_XN), (const bf16*)(F.ws + WS_WIN), DM, DM, DM};
        pg8::XcdRowOrder S; S.b.init(MR, INC, F.G, (int)blockIdx.x);
        EpiIn E{F.ws, F.out, F.in[15], F.in[16]};
        for (int i = 0; i < ((F.vcu >> 3) & 3); ++i) __builtin_amdgcn_s_sleep(100);
        F.pacc += pg8::gemm_phase<EpiIn, pg8::XcdRowOrder, true>(F.lds + RING_OFF, g, S, E, 1);
        if (BOTH(1)) GRID_BAR();
    }

    if (IN(2)) {
        float lam, mshift;
        { const int l = F.lane;
          const float e1 = wave_sum(F.in[18][l] * F.in[19][l]), e2 = wave_sum(F.in[20][l] * F.in[21][l]);
          lam = expf(e1) - expf(e2) + LAM_INIT;
          const float gq = wave_max(fabsf(F.in[15][l])), gk = wave_max(fabsf(F.in[16][l]));
          float bm = fmaxf(fmaxf(F.in[17][l], F.in[17][64 + l]), fmaxf(F.in[17][128 + l], F.in[17][192 + l])); bm = wave_max(bm);
          mshift = fminf(8.f * gq * gk * LOG2E + fmaxf(bm, 0.f) * LOG2E, 60.f);
          if (F.tid == 0) { F.MISC[16] = __builtin_bit_cast(unsigned, lam); F.MISC[17] = __builtin_bit_cast(unsigned, mshift); }
          __syncthreads(); }
        const int vcu = F.vcu;
        for (int rep = 0; rep < (PROBE_DUP == 2 ? 2 : 1); ++rep)
        for (int i = vcu; i < 512; i += F.G) lru_unit(F, i >> 3, i & 7);
        {
            const bool bal = (F.G == 256);
            const int x = vcu >> 5, j = vcu & 31, s = j & 7, srnd = 4 * ((vcu >> 3) & 3);
            const int nU = bal ? (PROBE_DUP == 4 ? 32 : 16) : (4096 + F.G - 1) / F.G;
            for (int u = 0; u < nU; ++u) {
                const int si = bal ? vcu : vcu + u * F.G;
                if (bal ? (u == srnd || (PROBE_DUP == 3 && u == srnd + 1)) : (si < 256)) attn_unit<true>(F, si >> 3, si & 7, 0, 0.f, 0.f);
                int bh, qb;
                if (bal) { bh = 32 * x + 4 * ((u & 15) >> 1) + (j >> 3); qb = (u & 1) ? s : 15 - s; }
                else { const int p = vcu + u * F.G; if (p >= 4096) break; bh = p >> 4; qb = p & 15; }
                attn_prompt(F, bh >> 3, bh & 7, qb, 0.f, 0.f);
            }
        }
        if (BOTH(2)) GROUP_BAR(0);
    }

    if (IN(3)) {
        pg8::Gemm g{(const bf16*)(F.ws + WS_YAB), (const bf16*)(F.ws + WS_WAB), 2 * DM, 2 * DM, DM};
        pg8::PairOrder S; S.b.init(MP, DM, F.G, (int)blockIdx.x);
        EpiProj E{(const bf16*)(F.ws + WS_GA), (const bf16*)(F.ws + WS_GB), (bf16*)(F.ws + WS_XN)};
        for (int rep = 0; rep < (PROBE_DUP == 5 ? 2 : 1); ++rep) pg8::gemm_phase<EpiProj, pg8::PairOrder, false>(F.lds + RING_OFF, g, S, E, 0);
        for (int c = F.vcu; c < 256; c += F.G) sample_block<3>(F, c);
        if (BOTH(3)) GROUP_BAR(1);
    }

    if (IN(4)) {
        pg8::Gemm g{(const bf16*)(F.ws + WS_XN), (const bf16*)(F.ws + WS_WOUT), DM, DM, DM};
        pg8::StaticOrder S; S.init(MP, DM, F.G, (int)blockIdx.x);
        EpiOut E{F.in[0], F.in[1], F.out};
        for (int rep = 0; rep < (PROBE_DUP == 6 ? 2 : 1); ++rep) pg8::gemm_phase<EpiOut, pg8::StaticOrder, false>(F.lds + RING_OFF, g, S, E, 0);
        for (int c = F.vcu; c < 256; c += F.G) sample_block<4>(F, c);
    }
    if (PROBE_TS != 0 && blockIdx.x == 0) { const unsigned long long st = __builtin_amdgcn_s_memrealtime(), dur = F.pacc * PROBE_MULT;
        while (__builtin_amdgcn_s_memrealtime() - st < dur) __builtin_amdgcn_s_sleep(8); }
#undef IN
#undef BOTH
}

extern "C" void kernel_launch(void* const* d_in, const int* in_sizes, int n_in, void* d_out, int out_size, void* d_ws, size_t ws_size, hipStream_t stream) {
    static int grid = 0;
    if (grid == 0) {
        if (n_in != 26 || in_sizes[0] != MP * DM || (size_t)out_size != O_END || ws_size < WS_END) {
            fprintf(stderr, "kernel_launch: shape mismatch: n_in %d in0 %d out %d ws %zu (need %zu); nothing launched\n", n_in, n_in > 0 ? in_sizes[0] : -1, out_size, ws_size, (size_t)WS_END); grid = -1; return; }
        int dev = 0, cus = 0, per_cu = 0;
        if (hipGetDevice(&dev) != hipSuccess || hipDeviceGetAttribute(&cus, hipDeviceAttributeMultiprocessorCount, dev) != hipSuccess) { grid = -1; return; }
        if (hipFuncSetAttribute((const void*)skel_fwd, hipFuncAttributeMaxDynamicSharedMemorySize, LDS_BYTES) != hipSuccess) { fprintf(stderr, "kernel_launch: hipFuncSetAttribute failed\n"); grid = -1; return; }
        if (hipOccupancyMaxActiveBlocksPerMultiprocessor(&per_cu, (const void*)skel_fwd, NWAVES * 64, LDS_BYTES) != hipSuccess || per_cu < 1)
            fprintf(stderr, "kernel_launch: note: occupancy query reports %d workgroups per CU\n", per_cu);
        (void)hipGetLastError();
        grid = cus;
    }
    if (grid < 0) return;
    if (hipMemsetAsync((char*)d_ws + WS_CTL, 0, CTL_ZERO_BYTES, stream) != hipSuccess) return;
    Args a{};
    for (int i = 0; i < 26; ++i) a.in[i] = (const float*)d_in[i];
    a.out = (float*)d_out; a.ws = (unsigned char*)d_ws;
    for (int li = 0; li < N_LAUNCHES; ++li) {
        a.ph_lo = (N_LAUNCHES == 1) ? 0 : li; a.ph_hi = (N_LAUNCHES == 1) ? PER_PHASE : li + 1; a.li = li; a.pad = 0;
        hipLaunchKernelGGL(skel_fwd, dim3(grid), dim3(NWAVES * 64), LDS_BYTES, stream, a);
        const hipError_t le = hipPeekAtLastError();
        if (le != hipSuccess) { fprintf(stderr, "kernel_launch: launch %d failed: %s\n", li, hipGetErrorName(le)); break; }
    }
}
```

```cpp
#include <hip/hip_runtime.h>
#include <cstdio>
#include <cstdint>
#include <type_traits>

#ifndef MK_N_LAUNCHES
#define MK_N_LAUNCHES 1
#endif
#ifndef PROBE_DUP
#define PROBE_DUP 0
#endif
#ifndef PROBE_TS
#define PROBE_TS 0
#endif
#ifndef PROBE_MULT
#define PROBE_MULT 10
#endif
#define PTS_BEGIN(id, cond) do { if (PROBE_TS == (id) && blockIdx.x == 0 && (cond)) F.pt0 = __builtin_amdgcn_s_memrealtime(); } while (0)
#define PTS_END(id, cond) do { if (PROBE_TS == (id) && blockIdx.x == 0 && (cond)) F.pacc += __builtin_amdgcn_s_memrealtime() - F.pt0; } while (0)

namespace pg8 {
#define PG8_LAS __attribute__((address_space(3)))
typedef unsigned short bf16_t;
typedef short bf16x8 __attribute__((ext_vector_type(8)));
typedef float f32x4 __attribute__((ext_vector_type(4)));
typedef unsigned u32x4 __attribute__((ext_vector_type(4)));
constexpr int BM = 256, BK = 64, HALF = 128, HTB = HALF * BK * 2, STAGE_BYTES = 8 * HTB, NXCD = 8, WGM = 8;

__host__ __device__ __forceinline__ int lds_byte(int r, int c) { const int st = (r >> 4) * 2 + (c >> 5), rr = r & 15, cc = c & 31, ob = rr * 64 + cc * 2; return st * 1024 + (ob ^ (((ob >> 9) & 1) << 5)); }
__host__ __device__ __forceinline__ void stage_rc(int b, int& R, int& C) { const int st = b / 1024, sb = b % 1024, swz = sb ^ (((sb >> 9) & 1) << 5); R = (st >> 1) * 16 + swz / 64; C = (st & 1) * 32 + (swz % 64) / 2; }
__host__ __device__ __forceinline__ int perm32(int rho) { const int n = rho >> 4, i = rho & 15; return 8 * (i >> 2) + 4 * n + (i & 3); }

struct Unit { int pm, pn, kp; };
struct Gemm { const bf16_t* A; const bf16_t* Bt; int lda, ldb, K; };

struct StaticOrder {
    int nM, nN, nwg, G, c;
    __host__ __device__ void init(int M, int N, int G_, int c_) { nM = M / BM; nN = N / BM; nwg = nM * nN; G = G_; c = c_; }
    __host__ __device__ bool map(long L, Unit& u) const {
        if (L >= nwg) return false;
        int wgid = (int)L; { const int q = nwg / NXCD, r = nwg % NXCD, xcd = wgid % NXCD, off = wgid / NXCD; wgid = (xcd < r ? xcd * (q + 1) : r * (q + 1) + (xcd - r) * q) + off; }
        const int nig = WGM * nN, gid = wgid / nig, fm = gid * WGM, gsz = (nM - fm) < WGM ? (nM - fm) : WGM;
        u.pm = fm + ((wgid % nig) % gsz); u.pn = (wgid % nig) / gsz; u.kp = 0; return true;
    }
    __host__ __device__ bool next(int i, Unit& u) const { if (PROBE_DUP == 1 && nN == 32) { if (i >= 66) return false; if (i >= 33) i -= 33; } return map((long)i * G + c, u); }
};
struct XcdRowOrder {
    StaticOrder b;
    __host__ __device__ bool next(int i, Unit& u) const {
        if (b.G != 256 || b.nM != 264 || b.nN != 32) return b.next(i, u);
        if (i > 32) return false;
        const int x = b.c & 7, k = b.c >> 3;
        if (i < 32) { const int g = i >> 3, ci = (i + x) & 7; u.pm = 33 * x + 8 * g + (k & 7); u.pn = 4 * ci + (k >> 3); }
        else { u.pm = 33 * (k & 7) + 32; u.pn = 8 * (k >> 3) + x; }
        u.kp = 0; return true;
    }
};
struct PairOrder {
    StaticOrder b;
    __host__ __device__ bool next(int i, Unit& u) const { if (!b.map((long)(i >> 1) * b.G + b.c, u)) return false; u.kp = i & 1; return true; }
};

__device__ __forceinline__ unsigned cvt_pk_bf16(float lo, float hi) { unsigned r; asm volatile("v_cvt_pk_bf16_f32 %0, %1, %2" : "=v"(r) : "v"(lo), "v"(hi)); return r; }

template <class Epi, class Sched, bool ALIGN_EPI>
__device__ __forceinline__ unsigned long long gemm_phase(PG8_LAS unsigned char* lds, const Gemm g, const Sched& S, const Epi& E, const int probe_id) {
    unsigned long long pacc = 0, pt0 = 0, pt1 = 0;
    const int tid = threadIdx.x, wid = __builtin_amdgcn_readfirstlane(tid >> 6), lane = tid & 63, wr = wid >> 2, wc = wid & 3, fr = lane & 15, fq = lane >> 4;
    const int K = g.K, nt = K / BK;
    unsigned voffA[2], voffB[2];
#pragma unroll
    for (int i = 0; i < 2; ++i) { int R, C; stage_rc(tid * 16 + i * 8192, R, C); const int Rb = Epi::PERM ? ((R & ~31) + perm32(R & 31)) : R;
        voffA[i] = (unsigned)(R * g.lda + C) * 2u; voffB[i] = (unsigned)(Rb * g.ldb + C) * 2u; }
    const size_t kstep = (size_t)(BK * 2);
    const size_t hstepA = (size_t)HALF * g.lda * 2, hstepB = (size_t)HALF * g.ldb * 2;
    const size_t tstepA = 2 * hstepA, tstepB = 2 * hstepB;
    const unsigned ldsw = (unsigned)wid * 1024u;
    const int aoff = lds_byte(wr * 64 + fr, fq * 8), boff = lds_byte(wc * 32 + fr, fq * 8);
#define PG8_SA(b, h) (((b) * 2 + (h)) * HTB)
#define PG8_SB(b, h) ((4 + (b) * 2 + (h)) * HTB)
#define PG8_STAGE(bufoff, gbase, voff) do { _Pragma("unroll") for (int _i = 0; _i < 2; ++_i) \
        __builtin_amdgcn_global_load_lds((const unsigned*)((const char*)(gbase) + (voff)[_i]), (PG8_LAS unsigned*)(lds + (bufoff) + ldsw + _i * 8192), 16, 0, 0); } while (0)
#define PG8_LDA(dst, b, h) do { _Pragma("unroll") for (int m = 0; m < 4; ++m) _Pragma("unroll") for (int k = 0; k < 2; ++k) dst[m][k] = *(const PG8_LAS bf16x8*)(lds + PG8_SA(b, h) + aoff + m * 2048 + k * 1024); } while (0)
#define PG8_LDB(dst, b, h) do { _Pragma("unroll") for (int n = 0; n < 2; ++n) _Pragma("unroll") for (int k = 0; k < 2; ++k) dst[n][k] = *(const PG8_LAS bf16x8*)(lds + PG8_SB(b, h) + boff + n * 2048 + k * 1024); } while (0)
#define PG8_MMA(ai, bj, At, Bt) do { __builtin_amdgcn_s_setprio(1); _Pragma("unroll") for (int m = 0; m < 4; ++m) _Pragma("unroll") for (int n = 0; n < 2; ++n) _Pragma("unroll") for (int k = 0; k < 2; ++k) \
        acc[ai][bj][m][n] = __builtin_amdgcn_mfma_f32_16x16x32_bf16(Bt[n][k], At[m][k], acc[ai][bj][m][n], 0, 0, 0); __builtin_amdgcn_s_setprio(0); } while (0)
#define PG8_WAIT_V(n) asm volatile("s_waitcnt vmcnt(" #n ")" ::: "memory")
#define PG8_WAIT_L(n) asm volatile("s_waitcnt lgkmcnt(" #n ")" ::: "memory")
#define PG8_BAR __builtin_amdgcn_s_barrier()
#define PG8_SCHED __builtin_amdgcn_sched_barrier(0)
    Unit cur, nxt; int ui = 0;
    if (!S.next(0, cur)) return 0;
    f32x4 acc[2][2][4][2];
#pragma unroll
    for (int a = 0; a < 2; ++a)
#pragma unroll
        for (int b = 0; b < 2; ++b)
#pragma unroll
            for (int m = 0; m < 4; ++m)
#pragma unroll
                for (int n = 0; n < 2; ++n) acc[a][b][m][n] = (f32x4){0.f, 0.f, 0.f, 0.f};
    bf16x8 At[4][2], B0[2][2], B1[2][2];
    const char* cA = (const char*)g.A + (size_t)cur.pm * tstepA + (size_t)cur.kp * K * 2; const char* cB = (const char*)g.Bt + (size_t)cur.pn * tstepB + (size_t)cur.kp * K * 2;
    PG8_STAGE(PG8_SB(0, 0), cB, voffB); PG8_STAGE(PG8_SB(0, 1), cB + hstepB, voffB); PG8_STAGE(PG8_SA(0, 0), cA, voffA); PG8_STAGE(PG8_SA(0, 1), cA + hstepA, voffA);
    if (wr == 1) PG8_BAR;
    PG8_WAIT_V(2); PG8_BAR;
    PG8_STAGE(PG8_SB(1, 0), cB + kstep, voffB); PG8_STAGE(PG8_SA(1, 0), cA + kstep, voffA); PG8_STAGE(PG8_SB(1, 1), cB + hstepB + kstep, voffB);
    PG8_WAIT_V(6); PG8_BAR;
    for (;;) {
        const bool has_next = S.next(ui + 1, nxt);
        if ((PROBE_TS == 4 || PROBE_TS == 6) && probe_id == 1 && blockIdx.x == 0) pt0 = __builtin_amdgcn_s_memrealtime();
        const char* nA = has_next ? (const char*)g.A + (size_t)nxt.pm * tstepA + (size_t)nxt.kp * K * 2 : cA; const char* nB = has_next ? (const char*)g.Bt + (size_t)nxt.pn * tstepB + (size_t)nxt.kp * K * 2 : cB;
        for (int t = 0; t < nt; t += 2) {
            const bool last = (t == nt - 2);
            const char* a1 = cA + (size_t)(t + 1) * kstep;
            const char* a2 = last ? nA : cA + (size_t)(t + 2) * kstep; const char* b2 = last ? nB : cB + (size_t)(t + 2) * kstep;
            const char* a3 = a2 + kstep; const char* b3 = b2 + kstep;
            PG8_LDB(B0, 0, 0); PG8_LDB(B1, 0, 1); PG8_SCHED; PG8_LDA(At, 0, 0); PG8_STAGE(PG8_SA(1, 1), a1 + hstepA, voffA);
            PG8_WAIT_V(8); PG8_WAIT_L(0); PG8_BAR; PG8_MMA(0, 0, At, B0); PG8_MMA(0, 1, At, B1); PG8_BAR; PG8_SCHED;
            PG8_LDA(At, 0, 1); PG8_STAGE(PG8_SB(0, 0), b2, voffB); PG8_STAGE(PG8_SB(0, 1), b2 + hstepB, voffB); PG8_STAGE(PG8_SA(0, 0), a2, voffA);
            PG8_WAIT_V(8); PG8_WAIT_L(0); PG8_BAR; PG8_MMA(1, 0, At, B0); PG8_MMA(1, 1, At, B1); PG8_BAR; PG8_SCHED;
            PG8_LDB(B0, 1, 0); PG8_LDB(B1, 1, 1); PG8_SCHED; PG8_LDA(At, 1, 0); PG8_STAGE(PG8_SA(0, 1), a2 + hstepA, voffA);
            PG8_WAIT_V(8); PG8_WAIT_L(0); PG8_BAR; PG8_MMA(0, 0, At, B0); PG8_MMA(0, 1, At, B1); PG8_BAR; PG8_SCHED;
            PG8_LDA(At, 1, 1); PG8_STAGE(PG8_SB(1, 0), b3, voffB); PG8_STAGE(PG8_SB(1, 1), b3 + hstepB, voffB); PG8_STAGE(PG8_SA(1, 0), a3, voffA);
            PG8_WAIT_V(8); PG8_WAIT_L(0); PG8_BAR; PG8_MMA(1, 0, At, B0); PG8_MMA(1, 1, At, B1); PG8_BAR; PG8_SCHED;
        }
        if constexpr (ALIGN_EPI) { if (wr == 0) PG8_BAR; }
        if (PROBE_TS == 4 && probe_id == 1 && blockIdx.x == 0) pacc += __builtin_amdgcn_s_memrealtime() - pt0;
        if (PROBE_TS == 5 && probe_id == 1 && blockIdx.x == 0) pt1 = __builtin_amdgcn_s_memrealtime();
        const bool keep = E(acc, cur, wr, wc, fr, fq);
        if (PROBE_TS == 5 && probe_id == 1 && blockIdx.x == 0) pacc += __builtin_amdgcn_s_memrealtime() - pt1;
        if (PROBE_TS == 6 && probe_id == 1 && blockIdx.x == 0 && (cur.pn >> 2) == 4) pacc += __builtin_amdgcn_s_memrealtime() - pt0;
        if (!has_next) break;
        if (!keep) {
#pragma unroll
        for (int a = 0; a < 2; ++a)
#pragma unroll
            for (int b = 0; b < 2; ++b)
#pragma unroll
                for (int m = 0; m < 4; ++m)
#pragma unroll
                    for (int n = 0; n < 2; ++n) acc[a][b][m][n] = (f32x4){0.f, 0.f, 0.f, 0.f};
        }
        cur = nxt; cA = nA; cB = nB; ++ui;
        if constexpr (ALIGN_EPI) { if (wr == 1) PG8_BAR; }
    }
    PG8_WAIT_V(0);
    if constexpr (!ALIGN_EPI) { if (wr == 0) PG8_BAR; }
    PG8_BAR;
    return pacc;
#undef PG8_SA
#undef PG8_SB
#undef PG8_STAGE
#undef PG8_LDA
#undef PG8_LDB
#undef PG8_MMA
#undef PG8_WAIT_V
#undef PG8_WAIT_L
#undef PG8_BAR
#undef PG8_SCHED
}
}

constexpr int NWAVES = 8;
constexpr int N_LAUNCHES = MK_N_LAUNCHES;
constexpr int PER_PHASE = 5;
constexpr int DM = 1024, SEQ = 2048, NB = 32, DSEQ = 64, PAST = 4096, NH = 8, INC = 8192;
constexpr int MP = NB * SEQ;
constexpr int MS = NB * DSEQ;
constexpr int MR = MP + MS;
constexpr float EPS = 1e-6f, LOG2E = 1.4426950408889634f;
constexpr float QSCALE = 0.125f * LOG2E;
constexpr float LAM_INIT = 0.2f;
constexpr size_t O_YP = 0, O_YS = 67108864, O_KP = 69206016, O_VP = 136314880, O_CP = 203423744, O_LP = 203522048,
                 O_KS = 203554816, O_VS = 205651968, O_CS = 207749120, O_LS = 207847424, O_END = 207880192;
constexpr size_t MiB = 1u << 20;
constexpr size_t ACT = (size_t)MR * DM * 2;
constexpr size_t WS_CTL = 0, CTL_ZERO_BYTES = 1 * MiB;
constexpr size_t WS_WIN = 2 * MiB, WS_WAB = 18 * MiB, WS_WOUT = 22 * MiB, WS_WG = 24 * MiB;
constexpr size_t WS_XN = 32 * MiB;
constexpr size_t WS_XA = WS_XN + ACT, WS_ZA = WS_XA + ACT, WS_Q = WS_ZA + ACT, WS_K = WS_Q + ACT, WS_V = WS_K + ACT, WS_ZB = WS_V + ACT, WS_GA = WS_ZB + ACT, WS_GB = WS_GA + ACT;
constexpr size_t WS_YAB = WS_GB + ACT;
constexpr size_t WS_END = WS_YAB + 2 * ACT;
constexpr int CW_TMO = 0, CW_BAR = 4096, CW_GRP = 8192;

constexpr int RING_OFF = 0, RING_BYTES = 131072;
constexpr int LDSCTL_OFF = RING_BYTES, MISC_OFF = LDSCTL_OFF + 320;
constexpr int LDS_BYTES = 147456;

#define GAS __attribute__((address_space(1)))
#define LAS __attribute__((address_space(3)))
typedef unsigned short bf16;
typedef unsigned v4u __attribute__((ext_vector_type(4)));
typedef float f32x4 __attribute__((ext_vector_type(4)));
typedef float f32x8 __attribute__((ext_vector_type(8)));
typedef float f32x16 __attribute__((ext_vector_type(16)));
typedef short bf16x8 __attribute__((ext_vector_type(8)));
typedef short s16x4 __attribute__((ext_vector_type(4)));
typedef GAS unsigned gu32;
#define RLX_AGENT __ATOMIC_RELAXED, __HIP_MEMORY_SCOPE_AGENT
#define LDS_WAIT() asm volatile("s_waitcnt lgkmcnt(0)" ::: "memory")
#define VM_WAIT() asm volatile("s_waitcnt vmcnt(0)" ::: "memory")
__device__ __forceinline__ unsigned pk2(float lo, float hi) { return pg8::cvt_pk_bf16(lo, hi); }
__device__ __forceinline__ float bf2f(unsigned short v) { return __builtin_bit_cast(float, (unsigned)v << 16); }
__device__ __forceinline__ float bflo(unsigned w) { return __builtin_bit_cast(float, w << 16); }
__device__ __forceinline__ float bfhi(unsigned w) { return __builtin_bit_cast(float, w & 0xffff0000u); }
__device__ __forceinline__ float sigm(float v) { return __builtin_amdgcn_rcpf(1.f + __builtin_amdgcn_exp2f(-LOG2E * v)); }

#define XB_TMO      128
#define XB_XCNT(j)  (256  + 64 * (j))
#define XB_XSUB(j)  (1280 + 64 * (j))
#define XB_XGEN(j)  (2304 + 64 * (j))
#define XB_TOP      3328
#define XB_TOPGEN   3392
#define XCD_BAR_WORDS 3456
#define XB_SPIN_CAP (1u << 18)
__device__ __forceinline__ unsigned xb_ld(unsigned* p)              { return __hip_atomic_load(p, __ATOMIC_RELAXED, __HIP_MEMORY_SCOPE_AGENT); }
__device__ __forceinline__ unsigned xb_add(unsigned* p, unsigned v) { return __hip_atomic_fetch_add(p, v, __ATOMIC_RELAXED, __HIP_MEMORY_SCOPE_AGENT); }
__device__ __forceinline__ unsigned xb_xcc_id() { return (unsigned)__builtin_amdgcn_s_getreg((3 << 11) | 20) & 0xFu; }
#define XB_SPIN(cond, bar) do { unsigned _sp = 0; while (cond) { __builtin_amdgcn_s_sleep(1); \
    if ((++_sp & 255u) == 0u) { if (xb_ld(&(bar)[XB_TMO])) break; if (_sp > XB_SPIN_CAP) { atomicAdd(&(bar)[XB_TMO], 1u); break; } } } } while (0)
struct XcdBarrier { unsigned* bar; unsigned x; volatile LAS unsigned* st; };
__device__ __forceinline__ XcdBarrier xcd_barrier_post(unsigned* bar, volatile LAS unsigned* st) {
    XcdBarrier b; b.bar = bar; b.x = xb_xcc_id(); b.st = st;
    if (threadIdx.x == 0) (void)xb_add(&bar[XB_XCNT(b.x)], 1u);
    return b;
}
__device__ __forceinline__ void xcd_barrier_complete(unsigned* bar, unsigned x, unsigned& nloc, unsigned& nx) {
    const unsigned G = gridDim.x * gridDim.y * gridDim.z;
    unsigned sum, cnt, mine, sp = 0u;
    for (;;) {
        sum = 0u; cnt = 0u; mine = 0u;
#pragma unroll
        for (unsigned j = 0; j < 16; ++j) { const unsigned c = xb_ld(&bar[XB_XCNT(j)]); sum += c; cnt += (c > 0u) ? 1u : 0u; mine = (j == x) ? c : mine; }
        if (sum == G) break;
        __builtin_amdgcn_s_sleep(1);
        if ((++sp & 255u) == 0u) { if (xb_ld(&bar[XB_TMO])) break; if (sp > XB_SPIN_CAP) { atomicAdd(&bar[XB_TMO], 1u); break; } }
    }
    nloc = mine > 0u ? mine : 1u; nx = cnt > 0u ? cnt : 1u;
}
__device__ __forceinline__ void xcd_barrier(const XcdBarrier& b) {
    asm volatile("s_waitcnt vmcnt(0)" ::: "memory");
    __syncthreads();
    if (threadIdx.x == 0) {
        unsigned* bar = b.bar;
        __builtin_amdgcn_s_waitcnt(0);
        unsigned nloc = b.st[0], nx = b.st[1];
        if (nloc == 0u) { xcd_barrier_complete(bar, b.x, nloc, nx); b.st[0] = nloc; b.st[1] = nx; }
        const unsigned old = xb_add(&bar[XB_XSUB(b.x)], 1u);
        const unsigned gen = old / nloc;
        if (old + 1u == (gen + 1u) * nloc) {
            __builtin_amdgcn_fence(__ATOMIC_RELEASE, "agent");
            asm volatile("s_waitcnt vmcnt(0)" ::: "memory");
            const unsigned og = xb_add(&bar[XB_TOP], 1u);
            const unsigned tg = og / nx;
            if (og + 1u == (tg + 1u) * nx) xb_add(&bar[XB_TOPGEN], 1u);
            else XB_SPIN(xb_ld(&bar[XB_TOPGEN]) == tg, bar);
            __builtin_amdgcn_fence(__ATOMIC_ACQUIRE, "agent");
            xb_add(&bar[XB_XGEN(b.x)], 1u);
            asm volatile("s_waitcnt vmcnt(0)" ::: "memory");
        } else {
            XB_SPIN(xb_ld(&bar[XB_XGEN(b.x)]) == gen, bar);
            __builtin_amdgcn_fence(__ATOMIC_ACQUIRE, "agent");
            asm volatile("s_waitcnt vmcnt(0)" ::: "memory");
        }
    }
    __syncthreads();
}

__device__ __forceinline__ void group_barrier(unsigned* bar, unsigned* cnt, const unsigned n, const bool t0) {
    asm volatile("s_waitcnt vmcnt(0)" ::: "memory");
    __syncthreads();
    if (t0) {
        __builtin_amdgcn_fence(__ATOMIC_RELEASE, "agent");
        asm volatile("s_waitcnt vmcnt(0)" ::: "memory");
        (void)xb_add(cnt, 1u);
        XB_SPIN(xb_ld(cnt) < n, bar);
        __builtin_amdgcn_fence(__ATOMIC_ACQUIRE, "agent");
        asm volatile("s_waitcnt vmcnt(0)" ::: "memory");
    }
    __syncthreads();
}

struct Frame {
    LAS unsigned char* lds;
    volatile LAS unsigned* MISC;
    gu32* ctl;
    int tid, lane, wave;
    int vcu, G;
    const float* in[26]; float* out; unsigned char* ws;
    unsigned long long pt0, pacc;
};
__device__ __forceinline__ float wave_sum(float v) {
#pragma unroll
    for (int o = 1; o < 64; o <<= 1) v += __shfl_xor(v, o);
    return v;
}
__device__ __forceinline__ float wave_max(float v) {
#pragma unroll
    for (int o = 1; o < 64; o <<= 1) v = fmaxf(v, __shfl_xor(v, o));
    return v;
}

__device__ __forceinline__ void p0_transpose_item(const float* W, int ldw, int k0, int n0, bf16* WT, int ldt, int trow0, int tcol0, LAS float* scr, int lane) {
#pragma unroll 8
    for (int i = 0; i < 32; ++i) { const int kk = 2 * i + (lane >> 5); scr[kk * 33 + (lane & 31)] = W[(size_t)(k0 + kk) * ldw + n0 + (lane & 31)]; }
    LDS_WAIT(); asm volatile("" ::: "memory");
    const int c = lane & 7;
#pragma unroll
    for (int j = 0; j < 4; ++j) { const int n = (lane >> 3) + 8 * j; const LAS float* s = scr + (8 * c) * 33 + n;
        v4u o; o.x = pk2(s[0 * 33], s[1 * 33]); o.y = pk2(s[2 * 33], s[3 * 33]); o.z = pk2(s[4 * 33], s[5 * 33]); o.w = pk2(s[6 * 33], s[7 * 33]);
        *(GAS v4u*)(WT + (size_t)(trow0 + n) * ldt + tcol0 + 8 * c) = o; }
    LDS_WAIT(); asm volatile("" ::: "memory");
}
__device__ __forceinline__ void rms_row_to_bf16(const float* xrow, const float* gain, bf16* orow, int lane) {
    const GAS f32x4* xr = (const GAS f32x4*)xrow + lane; const GAS f32x4* gr = (const GAS f32x4*)gain + lane;
    f32x4 v[4]; float s = 0.f;
#pragma unroll
    for (int j = 0; j < 4; ++j) { v[j] = xr[64 * j]; s += (v[j].x * v[j].x + v[j].y * v[j].y) + (v[j].z * v[j].z + v[j].w * v[j].w); }
    const float rinv = 1.f / sqrtf(wave_sum(s) * (1.f / DM) + EPS);
    GAS unsigned long long* o8 = (GAS unsigned long long*)orow + lane;
#pragma unroll
    for (int j = 0; j < 4; ++j) { const f32x4 g = gr[64 * j];
        o8[64 * j] = (unsigned long long)pk2(v[j].x * rinv * g.x, v[j].y * rinv * g.y) | ((unsigned long long)pk2(v[j].z * rinv * g.z, v[j].w * rinv * g.w) << 32); }
}
__device__ __forceinline__ void p0_prologue(Frame& F) {
    LAS float* scr = (LAS float*)(F.lds + RING_OFF + F.wave * 16384);
    const int gw = F.vcu * NWAVES + F.wave, NGW = F.G * NWAVES;
    bf16* WIN = (bf16*)(F.ws + WS_WIN); bf16* WAB = (bf16*)(F.ws + WS_WAB); bf16* WOUT = (bf16*)(F.ws + WS_WOUT); bf16* WG = (bf16*)(F.ws + WS_WG);
    constexpr int I_IN = 16 * 256, I_P = 16 * 32, I_G = 16 * 2 * 4;
    constexpr int NITEMS = I_IN + 3 * I_P + I_G;
    static_assert(MR / 4 >= NITEMS, "every wave must have at least as many row steps as weight items");
    auto do_item = [&](int r) {
        if (r < I_IN) { const int kb = r / 256, nb = r % 256, n0 = nb * 32; const int within = n0 & 255, wc = within >> 6, bj = (within >> 5) & 1;
            int trow = (n0 & ~255) + bj * 128 + wc * 32;
            if (n0 >= 6144) { const int gs = n0 >= 7168, oc0 = n0 - 6144 - 1024 * gs; trow = (24 + (oc0 >> 7)) * 256 + gs * 128 + ((oc0 >> 5) & 3) * 32; }
            p0_transpose_item(F.in[7], INC, kb * 64, n0, WIN, DM, trow, kb * 64, scr, F.lane); return; } r -= I_IN;
        if (r < I_P) { const int kb = r / 32, nb = r % 32; p0_transpose_item(F.in[23], DM, kb * 64, nb * 32, WAB, 2 * DM, nb * 32, kb * 64, scr, F.lane); return; } r -= I_P;
        if (r < I_P) { const int kb = r / 32, nb = r % 32; p0_transpose_item(F.in[24], DM, kb * 64, nb * 32, WAB, 2 * DM, nb * 32, DM + kb * 64, scr, F.lane); return; } r -= I_P;
        if (r < I_P) { const int kb = r / 32, nb = r % 32; p0_transpose_item(F.in[25], DM, kb * 64, nb * 32, WOUT, DM, nb * 32, kb * 64, scr, F.lane); return; } r -= I_P;
        { const int blk = r / 8, sub = r % 8, kb = sub / 4, nb = sub % 4, n = blk >> 1, g = blk & 1;
          p0_transpose_item((g ? F.in[12] : F.in[10]) + (size_t)n * 16384, 128, kb * 64, nb * 32, WG + (size_t)blk * 16384, 128, nb * 32, kb * 64, scr, F.lane); }
    };
    bf16* XN = (bf16*)(F.ws + WS_XN);
    f32x4 gv[4];
#pragma unroll
    for (int j = 0; j < 4; ++j) gv[j] = *((const GAS f32x4*)F.in[6] + F.lane + 64 * j);
    int it = gw;
    for (int m0 = gw * 4; m0 < MR; m0 += NGW * 4) {
        const float* xr = (m0 < MP) ? F.in[0] + (size_t)m0 * DM : F.in[1] + (size_t)(m0 - MP) * DM;
        f32x4 v[4][4];
#pragma unroll
        for (int r = 0; r < 4; ++r)
#pragma unroll
            for (int j = 0; j < 4; ++j) v[r][j] = *((const GAS f32x4*)(xr + (size_t)r * DM) + F.lane + 64 * j);
        __builtin_amdgcn_sched_barrier(0);
        if (it < NITEMS) { do_item(it); it += NGW; }
        __builtin_amdgcn_sched_barrier(0);
#pragma unroll
        for (int r = 0; r < 4; ++r) {
            float ssq = 0.f;
#pragma unroll
            for (int j = 0; j < 4; ++j) ssq += (v[r][j].x * v[r][j].x + v[r][j].y * v[r][j].y) + (v[r][j].z * v[r][j].z + v[r][j].w * v[r][j].w);
            const float rinv = 1.f / sqrtf(wave_sum(ssq) * (1.f / DM) + EPS);
            GAS unsigned long long* o8 = (GAS unsigned long long*)(XN + (size_t)(m0 + r) * DM) + F.lane;
#pragma unroll
            for (int j = 0; j < 4; ++j) o8[64 * j] = (unsigned long long)pk2(v[r][j].x * rinv * gv[j].x, v[r][j].y * rinv * gv[j].y) | ((unsigned long long)pk2(v[r][j].z * rinv * gv[j].z, v[r][j].w * rinv * gv[j].w) << 32);
        }
    }
}

__device__ __forceinline__ v4u pack8(const float* v) { v4u w; w.x = pk2(v[0], v[1]); w.y = pk2(v[2], v[3]); w.z = pk2(v[4], v[5]); w.w = pk2(v[6], v[7]); return w; }
struct EpiIn {
    static constexpr bool PERM = true;
    unsigned char* ws; float* out; const float* qg; const float* kg;
    __device__ __forceinline__ bool operator()(pg8::f32x4 (&acc)[2][2][4][2], const pg8::Unit& u, int wr, int wc, int fr, int fq) const {
        const int g = u.pn >> 2;
        const int cb = (u.pn & 3) * 256 + wc * 64 + fq * 8;
        const int row0 = u.pm * 256 + wr * 64 + fr;
        const bool smp = u.pm >= 256;
        if (g == 2 || g == 3) {
            const float* gn = (g == 2) ? qg : kg; const float sc = (g == 2) ? QSCALE : 1.f;
            float gv[2][8];
#pragma unroll
            for (int bj = 0; bj < 2; ++bj)
#pragma unroll
                for (int e = 0; e < 8; ++e) gv[bj][e] = gn[bj * 32 + fq * 8 + e] * sc;
            bf16* dstb = (bf16*)(ws + (g == 2 ? WS_Q : WS_K));
            float* kout = smp ? out + O_KS - (size_t)MP * DM : out + O_KP;
#pragma unroll
            for (int ai = 0; ai < 2; ++ai)
#pragma unroll
                for (int m = 0; m < 4; ++m) {
                    const size_t row = (size_t)(row0 + ai * 128 + m * 16);
                    float ss = 0.f;
#pragma unroll
                    for (int bj = 0; bj < 2; ++bj)
#pragma unroll
                        for (int n = 0; n < 2; ++n) { const pg8::f32x4 a = acc[ai][bj][m][n]; ss += (a.x * a.x + a.y * a.y) + (a.z * a.z + a.w * a.w); }
                    ss += __shfl_xor(ss, 16); ss += __shfl_xor(ss, 32);
                    const float rinv = 1.f / sqrtf(ss * (1.f / 64.f) + EPS);
#pragma unroll
                    for (int bj = 0; bj < 2; ++bj) {
                        float v[8];
#pragma unroll
                        for (int e = 0; e < 8; ++e) v[e] = acc[ai][bj][m][e >> 2][e & 3] * rinv * gv[bj][e];
                        *(GAS v4u*)(dstb + row * DM + cb + bj * 32) = pack8(v);
                        if (g == 3) { GAS f32x4* o = (GAS f32x4*)(kout + row * DM + cb + bj * 32); o[0] = (f32x4){v[0], v[1], v[2], v[3]}; o[1] = (f32x4){v[4], v[5], v[6], v[7]}; }
                    }
                }
            return false;
        }
        if (g >= 6) {
            bf16* Rb = (bf16*)(ws + WS_GA); bf16* Gb = (bf16*)(ws + WS_GB);
            const int oc = (u.pn - 24) * 128 + wc * 32 + fq * 8;
#pragma unroll
            for (int ai = 0; ai < 2; ++ai)
#pragma unroll
                for (int m = 0; m < 4; ++m) {
                    const size_t row = (size_t)(row0 + ai * 128 + m * 16);
                    float rr[8], gg[8];
#pragma unroll
                    for (int e = 0; e < 8; ++e) { const float ea = __builtin_amdgcn_exp2f(-LOG2E * acc[ai][0][m][e >> 2][e & 3]), eb = __builtin_amdgcn_exp2f(-LOG2E * acc[ai][1][m][e >> 2][e & 3]);
                        gg[e] = __builtin_amdgcn_rcpf(1.f + eb); rr[e] = fminf((1.f + eb) * __builtin_amdgcn_rcpf(1.f + ea), 1e20f); }
                    *(GAS v4u*)(Rb + row * DM + oc) = pack8(rr); *(GAS v4u*)(Gb + row * DM + oc) = pack8(gg);
                }
            return false;
        }
        bf16* dstb = (bf16*)(ws + (g == 0 ? WS_XA : g == 1 ? WS_ZA : g == 4 ? WS_V : WS_ZB));
        float* vout = smp ? out + O_VS - (size_t)MP * DM : out + O_VP;
#pragma unroll
        for (int ai = 0; ai < 2; ++ai)
#pragma unroll
            for (int m = 0; m < 4; ++m) {
                const int rowi = row0 + ai * 128 + m * 16; const size_t row = (size_t)rowi;
#pragma unroll
                for (int bj = 0; bj < 2; ++bj) {
                    float v[8];
#pragma unroll
                    for (int e = 0; e < 8; ++e) v[e] = acc[ai][bj][m][e >> 2][e & 3];
                    if (g == 0) {
                        const int t = smp ? (rowi & 63) : (rowi & 2047); const int T = smp ? 64 : 2048;
                        if (t >= T - 3) { const int b = smp ? ((rowi - MP) >> 6) : (rowi >> 11);
                            GAS f32x4* o = (GAS f32x4*)(out + (smp ? O_CS : O_CP) + (size_t)(b * 3 + (t - (T - 3))) * DM + cb + bj * 32);
                            o[0] = (f32x4){v[0], v[1], v[2], v[3]}; o[1] = (f32x4){v[4], v[5], v[6], v[7]}; }
                    } else if (g == 4) {
                        GAS f32x4* o = (GAS f32x4*)(vout + row * DM + cb + bj * 32); o[0] = (f32x4){v[0], v[1], v[2], v[3]}; o[1] = (f32x4){v[4], v[5], v[6], v[7]};
                    } else if (g == 1 || g == 5) {
#pragma unroll
                        for (int e = 0; e < 8; ++e) v[e] = v[e] * sigm(v[e]);
                    } else if (g == 6 || g == 7) {
#pragma unroll
                        for (int e = 0; e < 8; ++e) v[e] = sigm(v[e]);
                    }
                    *(GAS v4u*)(dstb + row * DM + cb + bj * 32) = pack8(v);
                }
            }
        return false;
    }
};
struct EpiProj {
    static constexpr bool PERM = true;
    const bf16* GA; const bf16* GB; bf16* MB;
    __device__ __forceinline__ bool operator()(pg8::f32x4 (&acc)[2][2][4][2], const pg8::Unit& u, int wr, int wc, int fr, int fq) const {
        const int row0 = u.pm * 256 + wr * 64 + fr, col0 = u.pn * 256 + wc * 32 + 8 * fq;
        v4u gA[2][2][2], gB[2][2][2];
#define LOADG(P, G, buf, q) do { _Pragma("unroll") for (int m = 0; m < 2; ++m) _Pragma("unroll") for (int bj = 0; bj < 2; ++bj) \
            G[buf][m][bj] = *(const GAS v4u*)((P) + (size_t)(row0 + ((q) >> 1) * 128 + (2 * ((q) & 1) + m) * 16) * DM + col0 + bj * 128); } while (0)
#define GV(e) ((e) & 1 ? bfhi(w_[(e) >> 1]) : bflo(w_[(e) >> 1]))
        if (u.kp == 0) {
            LOADG(GA, gA, 0, 0); __builtin_amdgcn_sched_barrier(0);
#pragma unroll
            for (int q = 0; q < 4; ++q) { const int ai = q >> 1, mh = q & 1, cb_ = q & 1;
                if (q + 1 < 4) LOADG(GA, gA, cb_ ^ 1, q + 1);
                __builtin_amdgcn_sched_barrier(0);
#pragma unroll
                for (int m = 0; m < 2; ++m)
#pragma unroll
                    for (int bj = 0; bj < 2; ++bj) { const unsigned w_[4] = {gA[cb_][m][bj].x, gA[cb_][m][bj].y, gA[cb_][m][bj].z, gA[cb_][m][bj].w};
#pragma unroll
                        for (int e = 0; e < 8; ++e) acc[ai][bj][2 * mh + m][e >> 2][e & 3] *= GV(e); }
                __builtin_amdgcn_sched_barrier(0);
            }
            return true;
        }
        LOADG(GB, gB, 0, 0); __builtin_amdgcn_sched_barrier(0);
#pragma unroll
        for (int q = 0; q < 4; ++q) { const int ai = q >> 1, mh = q & 1, cb_ = q & 1;
            if (q + 1 < 4) LOADG(GB, gB, cb_ ^ 1, q + 1);
            __builtin_amdgcn_sched_barrier(0);
#pragma unroll
            for (int m = 0; m < 2; ++m)
#pragma unroll
                for (int bj = 0; bj < 2; ++bj) { const unsigned w_[4] = {gB[cb_][m][bj].x, gB[cb_][m][bj].y, gB[cb_][m][bj].z, gB[cb_][m][bj].w};
                    float v[8];
#pragma unroll
                    for (int e = 0; e < 8; ++e) v[e] = acc[ai][bj][2 * mh + m][e >> 2][e & 3] * GV(e);
                    *(GAS v4u*)(MB + (size_t)(row0 + ai * 128 + (2 * mh + m) * 16) * DM + col0 + bj * 128) = pack8(v); }
            __builtin_amdgcn_sched_barrier(0);
        }
#undef LOADG
#undef GV
        return false;
    }
};
struct EpiOut {
    static constexpr bool PERM = false;
    const float* xp; const float* xs; float* out;
    __device__ __forceinline__ bool operator()(pg8::f32x4 (&acc)[2][2][4][2], const pg8::Unit& u, int wr, int wc, int fr, int fq) const {
        const int row0 = u.pm * 256 + wr * 64 + fr, col0 = u.pn * 256 + wc * 32 + 4 * fq;
        const float* xb = (u.pm >= 256) ? xs - (size_t)MP * DM : xp;
        f32x4 xv[2][2][2][2];
#define LOADX(buf, q) do { _Pragma("unroll") for (int m = 0; m < 2; ++m) _Pragma("unroll") for (int bj = 0; bj < 2; ++bj) _Pragma("unroll") for (int n = 0; n < 2; ++n) \
            xv[buf][m][bj][n] = *(const GAS f32x4*)(xb + (size_t)(row0 + ((q) >> 1) * 128 + (2 * ((q) & 1) + m) * 16) * DM + col0 + bj * 128 + n * 16); } while (0)
        LOADX(0, 0); __builtin_amdgcn_sched_barrier(0);
#pragma unroll
        for (int q = 0; q < 4; ++q) { const int ai = q >> 1, mh = q & 1, cb_ = q & 1;
            if (q + 1 < 4) LOADX(cb_ ^ 1, q + 1);
            __builtin_amdgcn_sched_barrier(0);
#pragma unroll
            for (int m = 0; m < 2; ++m)
#pragma unroll
                for (int bj = 0; bj < 2; ++bj)
#pragma unroll
                    for (int n = 0; n < 2; ++n) { const pg8::f32x4 a = acc[ai][bj][2 * mh + m][n]; const f32x4 x = xv[cb_][m][bj][n];
                        *(GAS f32x4*)(out + (size_t)(row0 + ai * 128 + (2 * mh + m) * 16) * DM + col0 + bj * 128 + n * 16) = (f32x4){x.x + a.x, x.y + a.y, x.z + a.z, x.w + a.w}; }
            __builtin_amdgcn_sched_barrier(0);
        }
#undef LOADX
        return false;
    }
};

constexpr int L_XCB = 0, L_RAW = 17408, L_HALO = L_RAW + 17408, L_BB = L_HALO + 1024;
static_assert(L_BB + 33792 <= RING_BYTES, "LRU LDS map");
__device__ __forceinline__ void lru_unit(Frame& F, int seq, int n) {
    const bool smp = seq >= 32; const int b = smp ? seq - 32 : seq; const int T = smp ? DSEQ : SEQ;
    const size_t rowbase = smp ? (size_t)MP + (size_t)b * DSEQ : (size_t)b * SEQ;
    int tid = F.tid; asm volatile("" : "+v"(tid));
    const int lane = tid & 63, w = F.wave;
    LAS unsigned char* L = F.lds;
    LAS bf16* XCB = (LAS bf16*)(L + L_XCB); LAS bf16* RAW = (LAS bf16*)(L + L_RAW); LAS bf16* HALO = (LAS bf16*)(L + L_HALO); LAS float* BB = (LAS float*)(L + L_BB);
    const bf16* XA = (const bf16*)(F.ws + WS_XA); const bf16* ZA = (const bf16*)(F.ws + WS_ZA); bf16* YAB = (bf16*)(F.ws + WS_YAB);
    const int ct = tid >> 4, cg = tid & 15, c0 = 128 * n + 8 * cg;
    float cw[4][8], cbias[8];
#pragma unroll
    for (int e = 0; e < 8; ++e) { cbias[e] = F.in[9][c0 + e];
#pragma unroll
        for (int j = 0; j < 4; ++j) cw[j][e] = F.in[8][j * DM + c0 + e]; }
    const int dl = 16 * w + (lane & 15), tq = lane >> 4, dg = 128 * n + dl;
    const float brg = F.in[11][dg], big = F.in[13][dg];
    float nsp; { const float x = -F.in[14][dg]; const float sp = fmaxf(x, 0.f) + log1pf(expf(-fabsf(x))); nsp = -8.f * LOG2E * sp; }
    bf16x8 Br[4], Bi[4];
    { const bf16* WG = (const bf16*)(F.ws + WS_WG) + (size_t)(2 * n) * 16384;
#pragma unroll
      for (int kk = 0; kk < 4; ++kk) { Br[kk] = *(const GAS bf16x8*)(WG + (size_t)dl * 128 + 32 * kk + 8 * tq); Bi[kk] = *(const GAS bf16x8*)(WG + 16384 + (size_t)dl * 128 + 32 * kk + 8 * tq); } }
    float hc = smp ? F.in[5][b * DM + dg] : 0.f;
    if (tid < 48) { const int hr = tid >> 4; float x[8];
        if (smp) { const GAS f32x4* sp_ = (const GAS f32x4*)(F.in[4] + (size_t)(b * 3 + hr) * DM + c0); const f32x4 s0 = sp_[0], s1 = sp_[1];
            x[0] = s0.x; x[1] = s0.y; x[2] = s0.z; x[3] = s0.w; x[4] = s1.x; x[5] = s1.y; x[6] = s1.z; x[7] = s1.w; }
        else {
#pragma unroll
            for (int e = 0; e < 8; ++e) x[e] = 0.f; }
        *(LAS v4u*)(HALO + hr * 136 + 8 * cg) = pack8(x); }
    v4u xr0, xr1; unsigned short zc[16], zn[16];
    const bf16* xsrc = XA + (rowbase + ct) * DM + c0; const bf16* zsrc = ZA + (rowbase + 4 * tq) * DM + dg;
    xr0 = *(const GAS v4u*)(xsrc); xr1 = *(const GAS v4u*)(xsrc + (size_t)32 * DM);
#pragma unroll
    for (int i = 0; i < 16; ++i) zc[i] = *(const GAS unsigned short*)(zsrc + (size_t)(16 * (i >> 2) + (i & 3)) * DM);
    for (int t0 = 0; t0 < T; t0 += 64) {
        *(LAS v4u*)(RAW + ct * 136 + 8 * cg) = xr0; *(LAS v4u*)(RAW + (ct + 32) * 136 + 8 * cg) = xr1;
        { const int tn = (t0 + 64 < T) ? t0 + 64 : t0;
          xr0 = *(const GAS v4u*)(xsrc + (size_t)tn * DM); xr1 = *(const GAS v4u*)(xsrc + (size_t)(tn + 32) * DM);
#pragma unroll
          for (int i = 0; i < 16; ++i) zn[i] = *(const GAS unsigned short*)(zsrc + (size_t)(tn + 16 * (i >> 2) + (i & 3)) * DM); }
        __syncthreads();
#pragma unroll
        for (int p = 0; p < 2; ++p) {
            const int t = ct + 32 * p;
            float a[8];
#pragma unroll
            for (int e = 0; e < 8; ++e) a[e] = cbias[e];
#pragma unroll
            for (int j = 0; j < 4; ++j) {
                const int tr = t + j - 3;
                const v4u q = (tr >= 0) ? *(const LAS v4u*)(RAW + tr * 136 + 8 * cg) : *(const LAS v4u*)(HALO + (tr + 3) * 136 + 8 * cg);
                const float x[8] = {bflo(q.x), bfhi(q.x), bflo(q.y), bfhi(q.y), bflo(q.z), bfhi(q.z), bflo(q.w), bfhi(q.w)};
#pragma unroll
                for (int e = 0; e < 8; ++e) a[e] += x[e] * cw[j][e];
            }
            *(LAS f32x4*)(BB + t * 132 + 8 * cg) = (f32x4){a[0], a[1], a[2], a[3]}; *(LAS f32x4*)(BB + t * 132 + 8 * cg + 4) = (f32x4){a[4], a[5], a[6], a[7]};
            *(LAS v4u*)(XCB + t * 136 + 8 * cg) = pack8(a);
        }
        if (tid < 48) *(LAS v4u*)(HALO + (tid >> 4) * 136 + 8 * cg) = *(const LAS v4u*)(RAW + (61 + (tid >> 4)) * 136 + 8 * cg);
        __syncthreads();
        {
            pg8::f32x4 ar[4], ai_[4];
#pragma unroll
            for (int tt = 0; tt < 4; ++tt) { ar[tt] = (pg8::f32x4){0.f, 0.f, 0.f, 0.f}; ai_[tt] = (pg8::f32x4){0.f, 0.f, 0.f, 0.f}; }
#pragma unroll
            for (int tt = 0; tt < 4; ++tt)
#pragma unroll
                for (int kk = 0; kk < 4; ++kk) {
                    const bf16x8 af = *(const LAS bf16x8*)(XCB + (16 * tt + (lane & 15)) * 136 + 32 * kk + 8 * tq);
                    ar[tt] = __builtin_amdgcn_mfma_f32_16x16x32_bf16(af, Br[kk], ar[tt], 0, 0, 0);
                    ai_[tt] = __builtin_amdgcn_mfma_f32_16x16x32_bf16(af, Bi[kk], ai_[tt], 0, 0, 0);
                }
            float A[4][4], B[4][4];
#pragma unroll
            for (int tt = 0; tt < 4; ++tt)
#pragma unroll
                for (int rg = 0; rg < 4; ++rg) {
                    const int t = 16 * tt + 4 * tq + rg;
                    const float r = sigm(ar[tt][rg] + brg), ig = sigm(ai_[tt][rg] + big);
                    const float av = __builtin_amdgcn_exp2f(r * nsp);
                    float mult = __builtin_amdgcn_sqrtf(fmaxf(__builtin_fmaf(-av, av, 1.f), 0.f));
                    if (!smp && (t0 + t) == 0) mult = 1.f;
                    A[tt][rg] = av; B[tt][rg] = mult * ig * BB[t * 132 + dl];
                }
#pragma unroll
            for (int tt = 0; tt < 4; ++tt)
#pragma unroll
                for (int rg = 1; rg < 4; ++rg) { B[tt][rg] = A[tt][rg] * B[tt][rg - 1] + B[tt][rg]; A[tt][rg] = A[tt][rg] * A[tt][rg - 1]; }
            float EA[4], EB[4], TA[4], TB[4];
#pragma unroll
            for (int tt = 0; tt < 4; ++tt) {
                float SA = A[tt][3], SB = B[tt][3];
                { const float pA = __shfl_up(SA, 16), pB = __shfl_up(SB, 16); if (tq >= 1) { SB = SA * pB + SB; SA = SA * pA; } }
                { const float pA = __shfl_up(SA, 32), pB = __shfl_up(SB, 32); if (tq >= 2) { SB = SA * pB + SB; SA = SA * pA; } }
                { const float pA = __shfl_up(SA, 16), pB = __shfl_up(SB, 16); EA[tt] = (tq >= 1) ? pA : 1.f; EB[tt] = (tq >= 1) ? pB : 0.f; }
                TA[tt] = __shfl(SA, (lane & 15) + 48); TB[tt] = __shfl(SB, (lane & 15) + 48);
            }
            const size_t r0 = rowbase + t0 + 4 * tq;
#pragma unroll
            for (int tt = 0; tt < 4; ++tt) {
                const float hin = EA[tt] * hc + EB[tt];
#pragma unroll
                for (int rg = 0; rg < 4; ++rg) { const float h = A[tt][rg] * hin + B[tt][rg];
                    const float y = h * bf2f(zc[4 * tt + rg]);
                    *(GAS unsigned short*)(YAB + (r0 + 16 * tt + rg) * (2 * DM) + dg) = (unsigned short)(pk2(y, 0.f) & 0xffffu); }
                hc = TA[tt] * hc + TB[tt];
            }
#pragma unroll
            for (int i = 0; i < 16; ++i) zc[i] = zn[i];
        }
    }
    if (tq == 0) F.out[(smp ? O_LS : O_LP) + (size_t)b * DM + dg] = hc;
    __syncthreads();
}

#define KSWZ(row, colB) ((row) * 256 + ((colB) ^ (((row) & 7) << 4)))
#define SBAR() __builtin_amdgcn_sched_barrier(0)
constexpr int A_V = 0, A_K = 32768, A_TB = 65536, A_WS = 66560;
__device__ __forceinline__ int crow(int r, int hi) { return (r & 3) + 8 * (r >> 2) + 4 * hi; }
__device__ __forceinline__ int v_st(int k, int c) { const int kk = (k & ~0xC) | ((k & 4) << 1) | ((k & 8) >> 1); return ((kk >> 3) * 4 + (c >> 5)) * 512 + ((kk & 7) * 32 + (c & 31)) * 2; }
__device__ __forceinline__ int v_rd_base(int lane) { return ((lane & 3) << 3) | (((lane >> 2) & 3) << 6) | (((lane >> 4) & 1) << 5) | (((lane >> 5) & 1) << 8); }
constexpr int v_rd_off(int d0, int ks, int half) { return d0 * 512 + ks * 4096 + half * 2048; }
template <int OFF> __device__ __forceinline__ s16x4 tr_read(int vb) {
    s16x4 r; asm volatile("ds_read_b64_tr_b16 %0, %1 offset:%2" : "=&v"(r) : "v"(vb), "i"(OFF) : "memory"); return r;
}
#define PKV(L, H) (bf16x8){L[0], L[1], L[2], L[3], H[0], H[1], H[2], H[3]}
template <int D0, int NKS> __device__ __forceinline__ void pv_one(f32x16& od, int vb, bf16x8 pa0, bf16x8 pa1, bf16x8 pa2, bf16x8 pa3) {
    const s16x4 l0 = tr_read<v_rd_off(D0, 0, 0)>(vb), h0 = tr_read<v_rd_off(D0, 0, 1)>(vb), l1 = tr_read<v_rd_off(D0, 1, 0)>(vb), h1 = tr_read<v_rd_off(D0, 1, 1)>(vb);
    if constexpr (NKS == 4) {
        const s16x4 l2 = tr_read<v_rd_off(D0, 2, 0)>(vb), h2 = tr_read<v_rd_off(D0, 2, 1)>(vb), l3 = tr_read<v_rd_off(D0, 3, 0)>(vb), h3 = tr_read<v_rd_off(D0, 3, 1)>(vb);
        asm volatile("s_waitcnt lgkmcnt(0)" ::: "memory"); SBAR();
        od = __builtin_amdgcn_mfma_f32_32x32x16_bf16(pa0, PKV(l0, h0), od, 0, 0, 0);
        od = __builtin_amdgcn_mfma_f32_32x32x16_bf16(pa1, PKV(l1, h1), od, 0, 0, 0);
        od = __builtin_amdgcn_mfma_f32_32x32x16_bf16(pa2, PKV(l2, h2), od, 0, 0, 0);
        od = __builtin_amdgcn_mfma_f32_32x32x16_bf16(pa3, PKV(l3, h3), od, 0, 0, 0);
    } else {
        asm volatile("s_waitcnt lgkmcnt(0)" ::: "memory"); SBAR();
        od = __builtin_amdgcn_mfma_f32_32x32x16_bf16(pa0, PKV(l0, h0), od, 0, 0, 0);
        od = __builtin_amdgcn_mfma_f32_32x32x16_bf16(pa1, PKV(l1, h1), od, 0, 0, 0);
    }
}
__device__ __forceinline__ bf16x8 tobf8(f32x8 x) { v4u w = {pk2(x[0], x[1]), pk2(x[2], x[3]), pk2(x[4], x[5]), pk2(x[6], x[7])}; return __builtin_bit_cast(bf16x8, w); }
__device__ __forceinline__ bf16x8 tobf8(bf16x8 x) { return x; }
__device__ __forceinline__ int rel_bucket(int rel) {
    const int n = rel < 0 ? -rel : rel; int bk;
    if (n < 8) bk = n; else { int k = (31 - __builtin_clz((unsigned)(n * n))) - 6; bk = 8 + k; if (bk > 15) bk = 15; }
    return bk + (rel > 0 ? 16 : 0);
}

template <bool SMP>
__device__ __forceinline__ void attn_unit(Frame& F, int b, int h, int qb, float lam, float mshift) {
    using ST = typename std::conditional<SMP, f32x8, bf16x8>::type;
    int tid = F.tid; asm volatile("" : "+v"(tid));
    const int lane = tid & 63, w = F.wave, r32 = lane & 31, hi = lane >> 5;
    const int m = w >> 2, rb = SMP ? ((w >> 1) & 1) : (w & 3), kh = SMP ? (w & 1) : 0;
    const int NT = SMP ? 66 : 2 * qb + 2;
    const int LT = SMP ? 64 : NT - 1;
    const int qpos0 = SMP ? PAST : 128 * qb;
    const size_t qrow0 = SMP ? (size_t)MP + (size_t)b * DSEQ : (size_t)b * SEQ + 128 * qb;
    const int qpw = qpos0 + 32 * rb, cw = qpw >> 6;
    LAS unsigned char* L = F.lds;
    LAS float* TB = (LAS float*)(L + A_TB); LAS float* WSF = (LAS float*)(L + A_WS) + w * 64;
    const bf16* QB = (const bf16*)(F.ws + WS_Q); const bf16* KB = (const bf16*)(F.ws + WS_K); const bf16* VB = (const bf16*)(F.ws + WS_V); const bf16* ZB = (const bf16*)(F.ws + WS_ZB);
    bf16* YAB = (bf16*)(F.ws + WS_YAB);
    if (tid < 255) TB[tid] = F.in[17][rel_bucket(tid - 191) * NH + h] * LOG2E - __builtin_bit_cast(float, F.MISC[17]);
    bf16x8 qr[4];
    { const bf16* Qw = QB + (qrow0 + 32 * rb + r32) * DM + h * 128 + m * 64 + hi * 8;
#pragma unroll
      for (int d0 = 0; d0 < 4; ++d0) qr[d0] = *(const GAS bf16x8*)(Qw + d0 * 16); }
    const int sr = tid >> 4, sc = (tid & 15) * 8, vst0 = v_st(sr, sc), vst1 = v_st(32 + sr, sc);
    const int vb0 = (int)(uintptr_t)(L + A_V) + v_rd_base(lane) + kh * 8192;
    struct Slot { ST v0, v1, k0, k1; } sA, sB;
    const float* ck = F.in[2] + ((size_t)b * PAST * NH + h) * 128 + sc; const float* cv = F.in[3] + ((size_t)b * PAST * NH + h) * 128 + sc;
    const float* nk = F.out + O_KS + ((size_t)b * DSEQ * NH + h) * 128 + sc; const float* nv = F.out + O_VS + ((size_t)b * DSEQ * NH + h) * 128 + sc;
    const bf16* pk = KB + ((size_t)b * SEQ) * DM + h * 128 + sc; const bf16* pvp = VB + ((size_t)b * SEQ) * DM + h * 128 + sc;
#define SLOAD(s, j) do { if constexpr (SMP) { const float* kp_ = ((j) < 64) ? ck + (size_t)(j) * 64 * DM : nk; const float* vp_ = ((j) < 64) ? cv + (size_t)(j) * 64 * DM : nv; \
        s.v0 = *(const GAS f32x8*)(vp_ + (size_t)sr * DM); s.v1 = *(const GAS f32x8*)(vp_ + (size_t)(32 + sr) * DM); \
        s.k0 = *(const GAS f32x8*)(kp_ + (size_t)sr * DM); s.k1 = *(const GAS f32x8*)(kp_ + (size_t)(32 + sr) * DM); } \
      else { const bf16* kp_ = pk + (size_t)(j) * 64 * DM; const bf16* vp_ = pvp + (size_t)(j) * 64 * DM; \
        s.v0 = *(const GAS ST*)(vp_ + (size_t)sr * DM); s.v1 = *(const GAS ST*)(vp_ + (size_t)(32 + sr) * DM); s.k0 = *(const GAS ST*)(kp_ + (size_t)sr * DM); s.k1 = *(const GAS ST*)(kp_ + (size_t)(32 + sr) * DM); } } while (0)
#define SWRITE(bo, s) do { *(LAS bf16x8*)(L + A_V + (bo) + vst0) = tobf8(s.v0); *(LAS bf16x8*)(L + A_V + (bo) + vst1) = tobf8(s.v1); \
        *(LAS bf16x8*)(L + A_K + (bo) + KSWZ(sr, sc * 2)) = tobf8(s.k0); *(LAS bf16x8*)(L + A_K + (bo) + KSWZ(32 + sr, sc * 2)) = tobf8(s.k1); } while (0)
    f32x16 o[4]; float l_reg = 0.f;
#pragma unroll
    for (int d = 0; d < 4; ++d)
#pragma unroll
        for (int r = 0; r < 16; ++r) o[d][r] = 0.f;
#define ITER(j, s, bo) do { \
        if constexpr (SMP) asm volatile("s_waitcnt vmcnt(8)" ::: "memory"); else asm volatile("s_waitcnt vmcnt(4)" ::: "memory"); \
        SWRITE(bo, s); __syncthreads(); \
        { const int jn_ = ((j) + 2 < LT) ? (j) + 2 : LT; const int jm_ = TMAP(jn_); SLOAD(s, jm_); } \
        if ((j) <= cw) { \
            f32x16 p0, p1; \
            const int jt_ = TMAP(j); \
            const int kofs = 64 * jt_ + 32 * kh; \
            if (jt_ >= cw - 2) { const int ib = kofs - (qpw + r32) + 191 + 4 * hi; \
                _Pragma("unroll") for (int r = 0; r < 16; ++r) { p0[r] = TB[ib + (r & 3) + 8 * (r >> 2)]; if constexpr (!SMP) p1[r] = TB[ib + 32 + (r & 3) + 8 * (r >> 2)]; } } \
            else { const float cf = TB[63]; _Pragma("unroll") for (int r = 0; r < 16; ++r) { p0[r] = cf; if constexpr (!SMP) p1[r] = cf; } } \
            const LAS unsigned char* Ks = L + A_K + (bo); \
            _Pragma("unroll") for (int d0 = 0; d0 < 4; ++d0) { const int cbb = (m * 64 + d0 * 16 + hi * 8) * 2; \
                const bf16x8 b0 = *(const LAS bf16x8*)(Ks + KSWZ(32 * kh + r32, cbb)); \
                p0 = __builtin_amdgcn_mfma_f32_32x32x16_bf16(b0, qr[d0], p0, 0, 0, 0); \
                if constexpr (!SMP) { const bf16x8 b1 = *(const LAS bf16x8*)(Ks + KSWZ(32 + r32, cbb)); p1 = __builtin_amdgcn_mfma_f32_32x32x16_bf16(b1, qr[d0], p1, 0, 0, 0); } } \
            float ps = 0.f; \
            _Pragma("unroll") for (int r = 0; r < 16; ++r) { p0[r] = __builtin_amdgcn_exp2f(p0[r]); ps += p0[r]; } \
            if constexpr (!SMP) { _Pragma("unroll") for (int r = 0; r < 16; ++r) { p1[r] = __builtin_amdgcn_exp2f(p1[r]); ps += p1[r]; } } \
            l_reg += ps; \
            bf16x8 pa0, pa1, pa2, pa3; \
            PK4(p0, 0, pa0); PK4(p0, 8, pa1); if constexpr (!SMP) { PK4(p1, 0, pa2); PK4(p1, 8, pa3); } else { pa2 = pa0; pa3 = pa1; } \
            SBAR(); \
            constexpr int NKS_ = SMP ? 2 : 4; \
            pv_one<0, NKS_>(o[0], vb0 + (bo), pa0, pa1, pa2, pa3); pv_one<1, NKS_>(o[1], vb0 + (bo), pa0, pa1, pa2, pa3); \
            pv_one<2, NKS_>(o[2], vb0 + (bo), pa0, pa1, pa2, pa3); pv_one<3, NKS_>(o[3], vb0 + (bo), pa0, pa1, pa2, pa3); \
        } } while (0)
#define PK4(P, BASE, OUT) do { unsigned a0 = pk2(P[BASE + 0], P[BASE + 1]), a1 = pk2(P[BASE + 2], P[BASE + 3]);   \
    unsigned b0_ = pk2(P[BASE + 4], P[BASE + 5]), b1_ = pk2(P[BASE + 6], P[BASE + 7]);                              \
    auto r0 = __builtin_amdgcn_permlane32_swap(a0, b0_, false, false); auto r1 = __builtin_amdgcn_permlane32_swap(a1, b1_, false, false); \
    v4u w_ = {r0[0], r1[0], r0[1], r1[1]}; OUT = __builtin_bit_cast(bf16x8, w_); } while (0)
    const int j0 = SMP ? (b * 8) % 65 : 0;
#define TMAP(i) (SMP ? (((i) + j0 >= 65) ? (i) + j0 - 65 : (i) + j0) : (i))
    { const int t0_ = TMAP(0), t1_ = TMAP(1); SLOAD(sA, t0_); SLOAD(sB, t1_); }
    for (int j = 0; j < NT; j += 2) {
        ITER(j, sA, 0);
        ITER(j + 1, sB, 16384);
    }
    asm volatile("s_waitcnt vmcnt(0)" ::: "memory");
#undef ITER
#undef TMAP
#undef PK4
#undef SLOAD
#undef SWRITE
    __syncthreads();
    { auto rr = __builtin_amdgcn_permlane32_swap(__float_as_uint(l_reg), __float_as_uint(l_reg), false, false); l_reg = __uint_as_float(rr[0]) + __uint_as_float(rr[1]); }
    LAS float* X = (LAS float*)L;
    bool active = true;
    if constexpr (SMP) {
        const int wp = w >> 1;
        if (kh == 1) {
#pragma unroll
            for (int r = 0; r < 16; ++r)
#pragma unroll
                for (int d0 = 0; d0 < 4; ++d0) X[((wp * 16 + r) * 4 + d0) * 64 + lane] = o[d0][r];
            WSF[r32] = l_reg;
        }
        __syncthreads();
        if (kh == 0) {
#pragma unroll
            for (int r = 0; r < 16; ++r)
#pragma unroll
                for (int d0 = 0; d0 < 4; ++d0) o[d0][r] += X[((wp * 16 + r) * 4 + d0) * 64 + lane];
            l_reg += WSF[64 + r32];
        }
        __syncthreads();
        active = (kh == 0);
    }
    const int rbq = rb;
    float fr_[16];
    if (active) {
        const float f = (m == 0 ? 1.f : __builtin_bit_cast(float, F.MISC[16])) / l_reg;
        if (hi == 0) WSF[r32] = f;
        LDS_WAIT();
#pragma unroll
        for (int r = 0; r < 16; ++r) fr_[r] = WSF[crow(r, hi)];
        if (m == 1) {
#pragma unroll
            for (int r = 0; r < 16; ++r)
#pragma unroll
                for (int d0 = 0; d0 < 4; ++d0) X[((rbq * 16 + r) * 4 + d0) * 64 + lane] = o[d0][r] * fr_[r];
        }
    }
    __syncthreads();
    if (active && m == 0) {
#pragma unroll
        for (int r = 0; r < 16; ++r)
#pragma unroll
            for (int d0 = 0; d0 < 4; ++d0) o[d0][r] = o[d0][r] * fr_[r] - X[((rbq * 16 + r) * 4 + d0) * 64 + lane];
    }
    __syncthreads();
    if (active && m == 0) {
#pragma unroll
        for (int r = 0; r < 16; ++r)
#pragma unroll
            for (int d0 = 0; d0 < 4; ++d0) X[(32 * rbq + crow(r, hi)) * 132 + 32 * d0 + r32] = o[d0][r];
    }
    __syncthreads();
    constexpr int R = SMP ? 64 : 128;
    if (tid < 4 * R) {
        const int row = tid >> 2, qd = tid & 3;
        const size_t grow = qrow0 + row;
        const bf16* zp = ZB + grow * DM + h * 128 + 32 * qd; bf16* yp = YAB + grow * (2 * DM) + DM + h * 128 + 32 * qd; const float* gp = F.in[22] + 32 * qd;
        v4u zz[4]; f32x4 gg[8];
#pragma unroll
        for (int i = 0; i < 4; ++i) zz[i] = *(const GAS v4u*)(zp + 8 * i);
#pragma unroll
        for (int i = 0; i < 8; ++i) gg[i] = *(const GAS f32x4*)(gp + 4 * i);
        float y[32]; float ss = 0.f;
#pragma unroll
        for (int i = 0; i < 8; ++i) { const f32x4 v = *(const LAS f32x4*)(X + row * 132 + 32 * qd + 4 * i); y[4 * i] = v.x; y[4 * i + 1] = v.y; y[4 * i + 2] = v.z; y[4 * i + 3] = v.w;
            ss += (v.x * v.x + v.y * v.y) + (v.z * v.z + v.w * v.w); }
        ss += __shfl_xor(ss, 1); ss += __shfl_xor(ss, 2);
        const float rinv = (1.f - LAM_INIT) / sqrtf(ss * (1.f / 128.f) + EPS);
        __builtin_amdgcn_sched_barrier(0);
#pragma unroll
        for (int i = 0; i < 4; ++i) { const v4u z = zz[i]; const f32x4 g0 = gg[2 * i], g1 = gg[2 * i + 1];
            float v[8];
            v[0] = y[8 * i] * rinv * g0.x * bflo(z.x); v[1] = y[8 * i + 1] * rinv * g0.y * bfhi(z.x); v[2] = y[8 * i + 2] * rinv * g0.z * bflo(z.y); v[3] = y[8 * i + 3] * rinv * g0.w * bfhi(z.y);
            v[4] = y[8 * i + 4] * rinv * g1.x * bflo(z.z); v[5] = y[8 * i + 5] * rinv * g1.y * bfhi(z.z); v[6] = y[8 * i + 6] * rinv * g1.z * bflo(z.w); v[7] = y[8 * i + 7] * rinv * g1.w * bfhi(z.w);
            *(GAS v4u*)(yp + 8 * i) = pack8(v); }
    }
    __syncthreads();
}

constexpr int P_SLOT = 32768, P_TB = 132096, P_WS = 133120;
static_assert(P_WS + 2048 <= LDS_BYTES, "prompt attention LDS map");
__device__ __forceinline__ void glds16(const void* gsrc, unsigned lds_dst) { unsigned keep;
    asm volatile("s_mov_b32 %0, m0\n\ts_mov_b32 m0, %2\n\ts_nop 0\n\tglobal_load_lds_dwordx4 %1, off\n\ts_mov_b32 m0, %0" : "=&s"(keep) : "v"(gsrc), "s"(lds_dst) : "memory"); }
#define WAIT_BAR0() asm volatile("s_waitcnt vmcnt(0) lgkmcnt(0)\n\ts_barrier" ::: "memory")
#define WAIT_BAR4() asm volatile("s_waitcnt vmcnt(4) lgkmcnt(0)\n\ts_barrier" ::: "memory")
__device__ __forceinline__ void attn_prompt(Frame& F, int b, int h, int qb, float lam, float mshift) {
    int tid = F.tid; asm volatile("" : "+v"(tid));
    const int lane = tid & 63, w = F.wave, r32 = lane & 31, hi = lane >> 5;
    const int m = w >> 2, rb = w & 3;
    const int NT = 2 * qb + 2;
    const size_t qrow0 = (size_t)b * SEQ + 128 * qb;
    const int qpw = 128 * qb + 32 * rb, cw = qpw >> 6;
    const bool vis = (cw == NT - 1);
    LAS unsigned char* L = F.lds;
    LAS float* TB = (LAS float*)(L + P_TB); LAS float* WSF = (LAS float*)(L + P_WS) + w * 64;
    const bf16* QB = (const bf16*)(F.ws + WS_Q); const bf16* ZB = (const bf16*)(F.ws + WS_ZB); bf16* YAB = (bf16*)(F.ws + WS_YAB);
    const bf16* Kt = (const bf16*)(F.ws + WS_K) + ((size_t)b * SEQ) * DM + h * 128; const bf16* Vt = (const bf16*)(F.ws + WS_V) + ((size_t)b * SEQ) * DM + h * 128;
    int ko[2], vo[2];
#pragma unroll
    for (int q = 0; q < 2; ++q) {
        const int row = 8 * w + 4 * q + (lane >> 4), cpos = lane & 15; ko[q] = row * DM + 8 * (cpos ^ (row & 7));
        const int c = w * 128 + q * 64 + lane, st = c >> 5, rowk = (c >> 2) & 7, cc = c & 3, kk = (st >> 2) * 8 + rowk, col = (st & 3) * 32 + cc * 8;
        const int k = (kk & ~0xC) | ((kk & 4) << 1) | ((kk & 8) >> 1); vo[q] = k * DM + col; }
    const unsigned lds0 = (unsigned)(uintptr_t)L;
    const unsigned dK = lds0 + w * 2048, dV = lds0 + 16384 + w * 2048;
#define DMA_TILE(j, so) do { const bf16* kb_ = Kt + (size_t)(j) * 64 * DM; const bf16* vb_ = Vt + (size_t)(j) * 64 * DM; \
        glds16(kb_ + ko[0], (unsigned)__builtin_amdgcn_readfirstlane(dK + (so))); glds16(kb_ + ko[1], (unsigned)__builtin_amdgcn_readfirstlane(dK + (so) + 1024)); \
        glds16(vb_ + vo[0], (unsigned)__builtin_amdgcn_readfirstlane(dV + (so))); glds16(vb_ + vo[1], (unsigned)__builtin_amdgcn_readfirstlane(dV + (so) + 1024)); } while (0)
    PTS_BEGIN(1, qb == 15 && F.pacc == 0); PTS_BEGIN(3, qb == 15 && F.pacc == 0);
    DMA_TILE(0, 0); DMA_TILE(1, P_SLOT);
    if (tid < 255) TB[tid] = F.in[17][rel_bucket(tid - 191) * NH + h] * LOG2E - __builtin_bit_cast(float, F.MISC[17]);
    bf16x8 qr[4];
    { const bf16* Qw = QB + (qrow0 + 32 * rb + r32) * DM + h * 128 + m * 64 + hi * 8;
#pragma unroll
      for (int d0 = 0; d0 < 4; ++d0) qr[d0] = *(const GAS bf16x8*)(Qw + d0 * 16); }
    const int vbase = (int)lds0 + 16384 + v_rd_base(lane);
    f32x16 o[4]; f32x16 ol;
    const bf16x8 ones = {0x3F80, 0x3F80, 0x3F80, 0x3F80, 0x3F80, 0x3F80, 0x3F80, 0x3F80};
#pragma unroll
    for (int d = 0; d < 4; ++d)
#pragma unroll
        for (int r = 0; r < 16; ++r) o[d][r] = 0.f;
#pragma unroll
    for (int r = 0; r < 16; ++r) ol[r] = 0.f;
    f32x16 pA0, pA1, pB0, pB1; bf16x8 pa0, pa1, pa2, pa3; f32x16 CF;
#define QKT(P0, P1, so, j) do { \
        const LAS unsigned char* Ks = L + (so); \
        { const int cbb = (m * 64 + hi * 8) * 2; \
          const bf16x8 b0 = *(const LAS bf16x8*)(Ks + KSWZ(r32, cbb)); const bf16x8 b1 = *(const LAS bf16x8*)(Ks + KSWZ(32 + r32, cbb)); \
          if ((j) >= cw - 2) { const int ib = 64 * (j) - (qpw + r32) + 191 + 4 * hi; \
              _Pragma("unroll") for (int r = 0; r < 16; ++r) { P0[r] = TB[ib + (r & 3) + 8 * (r >> 2)]; P1[r] = TB[ib + 32 + (r & 3) + 8 * (r >> 2)]; } \
              P0 = __builtin_amdgcn_mfma_f32_32x32x16_bf16(b0, qr[0], P0, 0, 0, 0); P1 = __builtin_amdgcn_mfma_f32_32x32x16_bf16(b1, qr[0], P1, 0, 0, 0); } \
          else { P0 = __builtin_amdgcn_mfma_f32_32x32x16_bf16(b0, qr[0], CF, 0, 0, 0); P1 = __builtin_amdgcn_mfma_f32_32x32x16_bf16(b1, qr[0], CF, 0, 0, 0); } } \
        _Pragma("unroll") for (int d0 = 1; d0 < 4; ++d0) { const int cbb = (m * 64 + d0 * 16 + hi * 8) * 2; \
            const bf16x8 b0 = *(const LAS bf16x8*)(Ks + KSWZ(r32, cbb)); const bf16x8 b1 = *(const LAS bf16x8*)(Ks + KSWZ(32 + r32, cbb)); \
            P0 = __builtin_amdgcn_mfma_f32_32x32x16_bf16(b0, qr[d0], P0, 0, 0, 0); P1 = __builtin_amdgcn_mfma_f32_32x32x16_bf16(b1, qr[d0], P1, 0, 0, 0); } } while (0)
#define PK4(P, BASE, OUT) do { unsigned a0 = pk2(P[BASE + 0], P[BASE + 1]), a1 = pk2(P[BASE + 2], P[BASE + 3]);   \
    unsigned b0_ = pk2(P[BASE + 4], P[BASE + 5]), b1_ = pk2(P[BASE + 6], P[BASE + 7]);                              \
    auto r0 = __builtin_amdgcn_permlane32_swap(a0, b0_, false, false); auto r1 = __builtin_amdgcn_permlane32_swap(a1, b1_, false, false); \
    v4u w_ = {r0[0], r1[0], r0[1], r1[1]}; OUT = __builtin_bit_cast(bf16x8, w_); } while (0)
#define FIN(P0, P1) do { PK4(P0, 0, pa0); PK4(P0, 8, pa1); PK4(P1, 0, pa2); PK4(P1, 8, pa3); } while (0)
#define EX2(X, i) X[i] = __builtin_amdgcn_exp2f(X[i])
#define VRD(D0, so, S) do { const int vb_ = vbase + (so); \
        S##l0 = tr_read<v_rd_off(D0, 0, 0)>(vb_); S##h0 = tr_read<v_rd_off(D0, 0, 1)>(vb_); S##l1 = tr_read<v_rd_off(D0, 1, 0)>(vb_); S##h1 = tr_read<v_rd_off(D0, 1, 1)>(vb_); \
        S##l2 = tr_read<v_rd_off(D0, 2, 0)>(vb_); S##h2 = tr_read<v_rd_off(D0, 2, 1)>(vb_); S##l3 = tr_read<v_rd_off(D0, 3, 0)>(vb_); S##h3 = tr_read<v_rd_off(D0, 3, 1)>(vb_); } while (0)
#define PVMF(D0, S, X, XB, DOEXP) do { \
        o[D0] = __builtin_amdgcn_mfma_f32_32x32x16_bf16(pa0, PKV(S##l0, S##h0), o[D0], 0, 0, 0); if (DOEXP) { EX2(X, XB + 0); EX2(X, XB + 1); } SBAR(); \
        o[D0] = __builtin_amdgcn_mfma_f32_32x32x16_bf16(pa1, PKV(S##l1, S##h1), o[D0], 0, 0, 0); if (DOEXP) { EX2(X, XB + 2); EX2(X, XB + 3); } SBAR(); \
        o[D0] = __builtin_amdgcn_mfma_f32_32x32x16_bf16(pa2, PKV(S##l2, S##h2), o[D0], 0, 0, 0); if (DOEXP) { EX2(X, XB + 4); EX2(X, XB + 5); } SBAR(); \
        o[D0] = __builtin_amdgcn_mfma_f32_32x32x16_bf16(pa3, PKV(S##l3, S##h3), o[D0], 0, 0, 0); if (DOEXP) { EX2(X, XB + 6); EX2(X, XB + 7); } SBAR(); } while (0)
#define LW(n) do { asm volatile("s_waitcnt lgkmcnt(" #n ")" ::: "memory"); SBAR(); } while (0)
#define PVALLH(so, X0, X1, DOEXP, H0, H1, H2, H3) do { \
        s16x4 val0, vah0, val1, vah1, val2, vah2, val3, vah3, vbl0, vbh0, vbl1, vbh1, vbl2, vbh2, vbl3, vbh3; \
        VRD(0, so, va); SBAR(); \
        ol = __builtin_amdgcn_mfma_f32_32x32x16_bf16(pa0, ones, ol, 0, 0, 0); ol = __builtin_amdgcn_mfma_f32_32x32x16_bf16(pa1, ones, ol, 0, 0, 0); \
        ol = __builtin_amdgcn_mfma_f32_32x32x16_bf16(pa2, ones, ol, 0, 0, 0); ol = __builtin_amdgcn_mfma_f32_32x32x16_bf16(pa3, ones, ol, 0, 0, 0); SBAR(); \
        VRD(1, so, vb); LW(8); PVMF(0, va, X0, 0, DOEXP); H0; SBAR(); \
        VRD(2, so, va); LW(8); PVMF(1, vb, X0, 8, DOEXP); H1; SBAR(); \
        VRD(3, so, vb); LW(8); PVMF(2, va, X1, 0, DOEXP); H2; SBAR(); \
        LW(0); PVMF(3, vb, X1, 8, DOEXP); H3; SBAR(); } while (0)
#define PVALL(so, X0, X1, DOEXP) PVALLH(so, X0, X1, DOEXP, (void)0, (void)0, (void)0, (void)0)
#define EXPALL(X0, X1) do { _Pragma("unroll") for (int r = 0; r < 16; ++r) { EX2(X0, r); EX2(X1, r); } } while (0)
    int s_prev = 0, s_cur = 0, s_next = P_SLOT, s_nn = 2 * P_SLOT;
#define ROT() do { s_prev = s_cur; s_cur = s_next; s_next = s_nn; s_nn = (s_nn == 3 * P_SLOT) ? 0 : s_nn + P_SLOT; } while (0)
    asm volatile("s_waitcnt vmcnt(0)" ::: "memory"); __syncthreads();
    { const float cf = TB[63];
#pragma unroll
      for (int r = 0; r < 16; ++r) CF[r] = cf; }
    { const int j2 = (2 < NT) ? 2 : NT - 1; DMA_TILE(j2, 2 * P_SLOT); }
    QKT(pA0, pA1, 0, 0); EXPALL(pA0, pA1);
    ROT();
#define STEP(C0, C1, R0, R1, j) do { \
        const int jn_ = ((j) + 2 < NT) ? (j) + 2 : NT - 1; const bf16* kb_ = Kt + (size_t)jn_ * 64 * DM; const bf16* vb_ = Vt + (size_t)jn_ * 64 * DM; \
        SBAR(); QKT(C0, C1, s_cur, j); FIN(R0, R1); SBAR(); \
        PVALLH(s_prev, C0, C1, true, \
            glds16(kb_ + ko[0], (unsigned)__builtin_amdgcn_readfirstlane(dK + s_nn)), glds16(kb_ + ko[1], (unsigned)__builtin_amdgcn_readfirstlane(dK + s_nn + 1024)), \
            glds16(vb_ + vo[0], (unsigned)__builtin_amdgcn_readfirstlane(dV + s_nn)), glds16(vb_ + vo[1], (unsigned)__builtin_amdgcn_readfirstlane(dV + s_nn + 1024))); \
        WAIT_BAR4(); ROT(); } while (0)
    for (int j = 1; j + 1 < NT; j += 2) {
        STEP(pB0, pB1, pA0, pA1, j);
        STEP(pA0, pA1, pB0, pB1, j + 1);
    }
    asm volatile("s_waitcnt vmcnt(0)" ::: "memory");
    SBAR(); if (vis) { QKT(pB0, pB1, s_cur, NT - 1); } FIN(pA0, pA1); SBAR();
    if (vis) { PVALL(s_prev, pB0, pB1, true); FIN(pB0, pB1); SBAR(); PVALL(s_cur, pB0, pB1, false); }
    else { PVALL(s_prev, pB0, pB1, false); }
#undef STEP
#undef ROT
#undef EXPALL
#undef PVALL
#undef PVALLH
#undef PVMF
#undef VRD
#undef LW
#undef EX2
#undef FIN
#undef PK4
#undef QKT
#undef DMA_TILE
    __syncthreads();
    PTS_END(1, qb == 15 && F.pt0 != 0 && F.pacc == 0); PTS_BEGIN(2, qb == 15 && F.pacc == 0);
    LAS float* X = (LAS float*)L;
    int tid2 = tid; asm volatile("" : "+v"(tid2));
    const int erow = tid2 >> 3, eoc = tid2 & 7;
    v4u zz[4]; f32x4 gg[4];
    { const bf16* zp = ZB + (qrow0 + erow) * DM + h * 128 + 8 * eoc; const float* gp = F.in[22] + 8 * eoc;
#pragma unroll
      for (int i = 0; i < 4; ++i) zz[i] = *(const GAS v4u*)(zp + (size_t)(i >> 1) * 64 * DM + 64 * (i & 1));
#pragma unroll
      for (int i = 0; i < 4; ++i) gg[i] = *(const GAS f32x4*)(gp + 64 * (i >> 1) + 4 * (i & 1)); }
    float fr_[16];
    { const float fm = (m == 0 ? 1.f : __builtin_bit_cast(float, F.MISC[16]));
#pragma unroll
      for (int r = 0; r < 16; ++r) fr_[r] = fm * __builtin_amdgcn_rcpf(ol[r]); }
    if (m == 1) {
#pragma unroll
        for (int r = 0; r < 16; ++r)
#pragma unroll
            for (int d0 = 0; d0 < 4; ++d0) X[((rb * 16 + r) * 4 + d0) * 64 + lane] = o[d0][r] * fr_[r];
    }
    __syncthreads();
    if (m == 0) {
#pragma unroll
        for (int r = 0; r < 16; ++r)
#pragma unroll
            for (int d0 = 0; d0 < 4; ++d0) o[d0][r] = o[d0][r] * fr_[r] - X[((rb * 16 + r) * 4 + d0) * 64 + lane];
    }
    __syncthreads();
    if (m == 0) {
#pragma unroll
        for (int r = 0; r < 16; ++r)
#pragma unroll
            for (int d0 = 0; d0 < 4; ++d0) X[(32 * rb + crow(r, hi)) * 132 + 32 * d0 + r32] = o[d0][r];
    }
    __syncthreads();
#pragma unroll
    for (int rr = 0; rr < 2; ++rr) {
        const int row = erow + 64 * rr;
        float y[16]; float ss = 0.f;
#pragma unroll
        for (int i = 0; i < 4; ++i) { const f32x4 v = *(const LAS f32x4*)(X + row * 132 + 64 * (i >> 1) + 8 * eoc + 4 * (i & 1)); y[4 * i] = v.x; y[4 * i + 1] = v.y; y[4 * i + 2] = v.z; y[4 * i + 3] = v.w;
            ss += (v.x * v.x + v.y * v.y) + (v.z * v.z + v.w * v.w); }
        ss += __shfl_xor(ss, 1); ss += __shfl_xor(ss, 2); ss += __shfl_xor(ss, 4);
        const float rinv = (1.f - LAM_INIT) / sqrtf(ss * (1.f / 128.f) + EPS);
        bf16* yp = YAB + (qrow0 + row) * (2 * DM) + DM + h * 128 + 8 * eoc;
#pragma unroll
        for (int j = 0; j < 2; ++j) { const v4u z = zz[2 * rr + j]; const f32x4 g0 = gg[2 * j], g1 = gg[2 * j + 1];
            float v[8];
            v[0] = y[8 * j] * rinv * g0.x * bflo(z.x); v[1] = y[8 * j + 1] * rinv * g0.y * bfhi(z.x); v[2] = y[8 * j + 2] * rinv * g0.z * bflo(z.y); v[3] = y[8 * j + 3] * rinv * g0.w * bfhi(z.y);
            v[4] = y[8 * j + 4] * rinv * g1.x * bflo(z.z); v[5] = y[8 * j + 5] * rinv * g1.y * bfhi(z.z); v[6] = y[8 * j + 6] * rinv * g1.z * bflo(z.w); v[7] = y[8 * j + 7] * rinv * g1.w * bfhi(z.w);
            *(GAS v4u*)(yp + 64 * j) = pack8(v); }
    }
    __syncthreads();
    PTS_END(2, qb == 15 && F.pt0 != 0 && F.pacc == 0); PTS_END(3, qb == 15 && F.pt0 != 0 && F.pacc == 0);
}

template <int PH>
__device__ __forceinline__ void sample_block(Frame& F, int c) {
    int tid = F.tid; asm volatile("" : "+v"(tid));
    const int lane = tid & 63, w = F.wave, r32 = lane & 31, hi = lane >> 5;
    const int rb = c >> 3, cb = c & 7, wr = w >> 2, wc = w & 3;
    constexpr int KA = (PH == 3) ? 2 * DM : DM, LDK = KA;
    const bf16* Ab = (PH == 3) ? (const bf16*)(F.ws + WS_YAB) : (const bf16*)(F.ws + WS_XN);
    const bf16* Bb = (PH == 3) ? (const bf16*)(F.ws + WS_WAB) : (const bf16*)(F.ws + WS_WOUT);
    LAS unsigned char* L = F.lds;
    const bf16* src[3]; int dst[3];
#pragma unroll
    for (int i = 0; i < 3; ++i) { const int p = tid + 512 * i, rowp = p >> 3, c8 = p & 7;
        src[i] = (rowp < 64) ? Ab + ((size_t)MP + 64 * rb + rowp) * LDK + 8 * c8 : Bb + (size_t)(128 * cb + rowp - 64) * LDK + 8 * c8;
        dst[i] = rowp * 144 + c8 * 16; }
    const int aoff = (32 * wr + r32) * 144 + hi * 16, boff = (64 + 32 * wc + r32) * 144 + hi * 16;
    f32x16 acc0, acc1;
#pragma unroll
    for (int r = 0; r < 16; ++r) { acc0[r] = 0.f; acc1[r] = 0.f; }
    v4u sA[3], sB[3];
#pragma unroll
    for (int i = 0; i < 3; ++i) { sA[i] = *(const GAS v4u*)(src[i]); sB[i] = *(const GAS v4u*)(src[i] + 64); }
#pragma unroll
    for (int i = 0; i < 3; ++i) *(LAS v4u*)(L + dst[i]) = sA[i];
#pragma unroll
    for (int i = 0; i < 3; ++i) sA[i] = *(const GAS v4u*)(src[i] + 128);
    __syncthreads();
    constexpr int BUFB = 192 * 144;
#define SB_STEP(k0, CUR, NXT, SW, SL) do { \
        bf16x8 a[4], b[4]; \
        _Pragma("unroll") for (int ks = 0; ks < 4; ++ks) { a[ks] = *(const LAS bf16x8*)(L + (CUR) + aoff + ks * 32); b[ks] = *(const LAS bf16x8*)(L + (CUR) + boff + ks * 32); } \
        if (PH == 3 && (k0) >= DM) { _Pragma("unroll") for (int ks = 0; ks < 4; ++ks) acc1 = __builtin_amdgcn_mfma_f32_32x32x16_bf16(a[ks], b[ks], acc1, 0, 0, 0); } \
        else { _Pragma("unroll") for (int ks = 0; ks < 4; ++ks) acc0 = __builtin_amdgcn_mfma_f32_32x32x16_bf16(a[ks], b[ks], acc0, 0, 0, 0); } \
        __builtin_amdgcn_sched_barrier(0); \
        _Pragma("unroll") for (int i = 0; i < 3; ++i) *(LAS v4u*)(L + (NXT) + dst[i]) = SW[i]; \
        { const int kn_ = ((k0) + 192 < KA) ? (k0) + 192 : KA - 64; _Pragma("unroll") for (int i = 0; i < 3; ++i) SW[i] = *(const GAS v4u*)(src[i] + kn_); } \
        __syncthreads(); } while (0)
    for (int k0 = 0; k0 < KA; k0 += 128) {
        SB_STEP(k0, 0, BUFB, sB, sA);
        SB_STEP(k0 + 64, BUFB, 0, sA, sB);
    }
#undef SB_STEP
    const size_t orow0 = (size_t)MP + 64 * rb + 32 * wr; const int ocol = 128 * cb + 32 * wc + r32;
    if (PH == 3) {
        const bf16* GA = (const bf16*)(F.ws + WS_GA); const bf16* GB = (const bf16*)(F.ws + WS_GB); bf16* MB = (bf16*)(F.ws + WS_XN);
        unsigned short ga[16], gb[16];
#pragma unroll
        for (int r = 0; r < 16; ++r) { const size_t off = (orow0 + crow(r, hi)) * DM + ocol; ga[r] = *(const GAS unsigned short*)(GA + off); gb[r] = *(const GAS unsigned short*)(GB + off); }
        __builtin_amdgcn_sched_barrier(0);
#pragma unroll
        for (int r = 0; r < 16; ++r) { const float v = bf2f(gb[r]) * (bf2f(ga[r]) * acc0[r] + acc1[r]);
            *(GAS unsigned short*)(MB + (orow0 + crow(r, hi)) * DM + ocol) = (unsigned short)(pk2(v, 0.f) & 0xffffu); }
    } else {
        const float* xs = F.in[1] - (size_t)MP * DM;
        float xv[16];
#pragma unroll
        for (int r = 0; r < 16; ++r) xv[r] = *(const GAS float*)(xs + (orow0 + crow(r, hi)) * DM + ocol);
        __builtin_amdgcn_sched_barrier(0);
#pragma unroll
        for (int r = 0; r < 16; ++r) *(GAS float*)(F.out + (orow0 + crow(r, hi)) * DM + ocol) = xv[r] + acc0[r];
    }
}

struct Args { const float* in[26]; float* out; unsigned char* ws; int ph_lo, ph_hi, li, pad; };
__global__ void __launch_bounds__(NWAVES * 64, 2) skel_fwd(Args args) {
    extern __shared__ __attribute__((aligned(16))) unsigned char lds[];
    Frame F;
    F.lds = (LAS unsigned char*)lds;
    F.MISC = (volatile LAS unsigned*)(F.lds + MISC_OFF);
    F.tid = threadIdx.x; F.lane = F.tid & 63; F.wave = __builtin_amdgcn_readfirstlane(F.tid >> 6);
    F.G = gridDim.x; { const int bx = blockIdx.x; F.vcu = (F.G % 8 == 0) ? (bx % 8) * (F.G / 8) + bx / 8 : bx; }
    F.ws = args.ws; F.out = args.out; F.ctl = (gu32*)(args.ws + WS_CTL); F.pt0 = 0; F.pacc = 0;
#pragma unroll
    for (int i = 0; i < 26; ++i) F.in[i] = args.in[i];
    for (int u = F.tid; u < (LDS_BYTES - LDSCTL_OFF) / 4; u += NWAVES * 64) ((LAS unsigned*)(F.lds + LDSCTL_OFF))[u] = 0u;
    __syncthreads();
    XcdBarrier bar; bar.bar = (unsigned*)(F.ctl + CW_BAR); bar.x = 0; bar.st = nullptr;
    if (N_LAUNCHES == 1) bar = xcd_barrier_post((unsigned*)(F.ctl + CW_BAR), F.MISC + 8);
#define GRID_BAR() do { if (N_LAUNCHES == 1) xcd_barrier(bar); } while (0)
#define GROUP_BAR(k) do { if (N_LAUNCHES == 1) { if (F.G == 256) group_barrier((unsigned*)(F.ctl + CW_BAR), (unsigned*)(F.ctl + CW_GRP) + ((k) * 8 + (F.vcu >> 5)) * 16, 32u, F.tid == 0); else xcd_barrier(bar); } } while (0)
    const int lo = args.ph_lo, hi = args.ph_hi;
#define IN(k) (lo <= (k) && (k) < hi)
#define BOTH(k) (IN(k) && IN((k) + 1))

    if (IN(0)) { for (int rep = 0; rep < (PROBE_DUP == 7 ? 2 : 1); ++rep) p0_prologue(F); if (BOTH(0)) GRID_BAR(); }

    if (IN(1)) {
        pg8::Gemm g{(const bf16*)(F.ws + WS_XN), (const bf16*)(F.ws + WS_WIN), DM, DM, DM};
        pg8::XcdRowOrder S; S.b.init(MR, INC, F.G, (int)blockIdx.x);
        EpiIn E{F.ws, F.out, F.in[15], F.in[16]};
        F.pacc += pg8::gemm_phase<EpiIn, pg8::XcdRowOrder, true>(F.lds + RING_OFF, g, S, E, 1);
        if (BOTH(1)) GRID_BAR();
    }

    if (IN(2)) {
        float lam, mshift;
        { const int l = F.lane;
          const float e1 = wave_sum(F.in[18][l] * F.in[19][l]), e2 = wave_sum(F.in[20][l] * F.in[21][l]);
          lam = expf(e1) - expf(e2) + LAM_INIT;
          const float gq = wave_max(fabsf(F.in[15][l])), gk = wave_max(fabsf(F.in[16][l]));
          float bm = fmaxf(fmaxf(F.in[17][l], F.in[17][64 + l]), fmaxf(F.in[17][128 + l], F.in[17][192 + l])); bm = wave_max(bm);
          mshift = fminf(8.f * gq * gk * LOG2E + fmaxf(bm, 0.f) * LOG2E, 60.f);
          if (F.tid == 0) { F.MISC[16] = __builtin_bit_cast(unsigned, lam); F.MISC[17] = __builtin_bit_cast(unsigned, mshift); }
          __syncthreads(); }
        const int vcu = F.vcu;
        for (int rep = 0; rep < (PROBE_DUP == 2 ? 2 : 1); ++rep)
        for (int i = vcu; i < 512; i += F.G) lru_unit(F, i >> 3, i & 7);
        {
            const bool bal = (F.G == 256);
            const int x = vcu >> 5, j = vcu & 31, s = j & 7, srnd = 4 * ((vcu >> 3) & 3);
            const int nU = bal ? (PROBE_DUP == 4 ? 32 : 16) : (4096 + F.G - 1) / F.G;
            for (int u = 0; u < nU; ++u) {
                const int si = bal ? vcu : vcu + u * F.G;
                if (bal ? (u == srnd || (PROBE_DUP == 3 && u == srnd + 1)) : (si < 256)) attn_unit<true>(F, si >> 3, si & 7, 0, 0.f, 0.f);
                int bh, qb;
                if (bal) { bh = 32 * x + 4 * ((u & 15) >> 1) + (j >> 3); qb = (u & 1) ? s : 15 - s; }
                else { const int p = vcu + u * F.G; if (p >= 4096) break; bh = p >> 4; qb = p & 15; }
                attn_prompt(F, bh >> 3, bh & 7, qb, 0.f, 0.f);
            }
        }
        if (BOTH(2)) GROUP_BAR(0);
    }

    if (IN(3)) {
        pg8::Gemm g{(const bf16*)(F.ws + WS_YAB), (const bf16*)(F.ws + WS_WAB), 2 * DM, 2 * DM, DM};
        pg8::PairOrder S; S.b.init(MP, DM, F.G, (int)blockIdx.x);
        EpiProj E{(const bf16*)(F.ws + WS_GA), (const bf16*)(F.ws + WS_GB), (bf16*)(F.ws + WS_XN)};
        for (int rep = 0; rep < (PROBE_DUP == 5 ? 2 : 1); ++rep) pg8::gemm_phase<EpiProj, pg8::PairOrder, false>(F.lds + RING_OFF, g, S, E, 0);
        for (int c = F.vcu; c < 256; c += F.G) sample_block<3>(F, c);
        if (BOTH(3)) GROUP_BAR(1);
    }

    if (IN(4)) {
        pg8::Gemm g{(const bf16*)(F.ws + WS_XN), (const bf16*)(F.ws + WS_WOUT), DM, DM, DM};
        pg8::StaticOrder S; S.init(MP, DM, F.G, (int)blockIdx.x);
        EpiOut E{F.in[0], F.in[1], F.out};
        for (int rep = 0; rep < (PROBE_DUP == 6 ? 2 : 1); ++rep) pg8::gemm_phase<EpiOut, pg8::StaticOrder, false>(F.lds + RING_OFF, g, S, E, 0);
        for (int c = F.vcu; c < 256; c += F.G) sample_block<4>(F, c);
    }
    if (PROBE_TS != 0 && blockIdx.x == 0) { const unsigned long long st = __builtin_amdgcn_s_memrealtime(), dur = F.pacc * PROBE_MULT;
        while (__builtin_amdgcn_s_memrealtime() - st < dur) __builtin_amdgcn_s_sleep(8); }
#undef IN
#undef BOTH
}

extern "C" void kernel_launch(void* const* d_in, const int* in_sizes, int n_in, void* d_out, int out_size, void* d_ws, size_t ws_size, hipStream_t stream) {
    static int grid = 0;
    if (grid == 0) {
        if (n_in != 26 || in_sizes[0] != MP * DM || (size_t)out_size != O_END || ws_size < WS_END) {
            fprintf(stderr, "kernel_launch: shape mismatch: n_in %d in0 %d out %d ws %zu (need %zu); nothing launched\n", n_in, n_in > 0 ? in_sizes[0] : -1, out_size, ws_size, (size_t)WS_END); grid = -1; return; }
        int dev = 0, cus = 0, per_cu = 0;
        if (hipGetDevice(&dev) != hipSuccess || hipDeviceGetAttribute(&cus, hipDeviceAttributeMultiprocessorCount, dev) != hipSuccess) { grid = -1; return; }
        if (hipFuncSetAttribute((const void*)skel_fwd, hipFuncAttributeMaxDynamicSharedMemorySize, LDS_BYTES) != hipSuccess) { fprintf(stderr, "kernel_launch: hipFuncSetAttribute failed\n"); grid = -1; return; }
        if (hipOccupancyMaxActiveBlocksPerMultiprocessor(&per_cu, (const void*)skel_fwd, NWAVES * 64, LDS_BYTES) != hipSuccess || per_cu < 1)
            fprintf(stderr, "kernel_launch: note: occupancy query reports %d workgroups per CU\n", per_cu);
        (void)hipGetLastError();
        grid = cus;
    }
    if (grid < 0) return;
    if (hipMemsetAsync((char*)d_ws + WS_CTL, 0, CTL_ZERO_BYTES, stream) != hipSuccess) return;
    Args a{};
    for (int i = 0; i < 26; ++i) a.in[i] = (const float*)d_in[i];
    a.out = (float*)d_out; a.ws = (unsigned char*)d_ws;
    for (int li = 0; li < N_LAUNCHES; ++li) {
        a.ph_lo = (N_LAUNCHES == 1) ? 0 : li; a.ph_hi = (N_LAUNCHES == 1) ? PER_PHASE : li + 1; a.li = li; a.pad = 0;
        hipLaunchKernelGGL(skel_fwd, dim3(grid), dim3(NWAVES * 64), LDS_BYTES, stream, a);
        const hipError_t le = hipPeekAtLastError();
        if (le != hipSuccess) { fprintf(stderr, "kernel_launch: launch %d failed: %s\n", li, hipGetErrorName(le)); break; }
    }
}
```
